# Optimizing an MI355X kernel written in HIP

```python
import functools
import jax, jax.numpy as jnp
from jax import lax
import numpy as np

D_MODEL = 1024
BATCH = 16
SEQ = 256
DEPTH = 1
DEC_BATCH = 8
DEC_SEQ = 2048
PAST_LEN = 256

GRID_W = 64
HEAD_DIM = 64
NA_HEADS = 8
NA_ROWS = 8
NA_COLS = 16
SWA_HEADS = 8
SWA_KV_HEADS = 2
SWA_GROUPS = SWA_HEADS // SWA_KV_HEADS
SWA_WINDOW = 128
BLOCK = 128
FFN_DIM = 2816
ROPE_BASE = 10000.0
EPS = 1e-6
NEG_INF = -1e30
N_MOD = 9
NA_WIDTH = NA_HEADS * HEAD_DIM
SWA_Q_WIDTH = SWA_HEADS * HEAD_DIM
SWA_KV_WIDTH = SWA_KV_HEADS * HEAD_DIM
IN_SPLITS = (NA_WIDTH, 2 * NA_WIDTH, 3 * NA_WIDTH,
             3 * NA_WIDTH + SWA_Q_WIDTH,
             3 * NA_WIDTH + SWA_Q_WIDTH + SWA_KV_WIDTH,
             3 * NA_WIDTH + SWA_Q_WIDTH + 2 * SWA_KV_WIDTH)
IN_COLS = IN_SPLITS[-1] + 2 * D_MODEL

kernel_name = "hybrid_diffusion_na_swa_step"


def rmsnorm(x, g):
    x32 = x.astype(jnp.float32)
    y = x32 * lax.rsqrt(jnp.mean(x32 * x32, axis=-1, keepdims=True) + EPS)
    return y.astype(x.dtype) * g


def adaln(cond, w_ada, b_ada):
    return (jax.nn.silu(cond) @ w_ada + b_ada).reshape(cond.shape[0], N_MOD, D_MODEL)


def modulate(x, g, shift, scale):
    return rmsnorm(x, g) * (1.0 + scale) + shift


def swiglu(h, w_gate, w_up, w_down):
    return (jax.nn.silu(h @ w_gate) * (h @ w_up)) @ w_down


def rope_1d(x, pos):
    half = x.shape[-1] // 2
    freqs = jnp.power(ROPE_BASE, -jnp.arange(half, dtype=jnp.float32) / half)
    ang = pos.astype(jnp.float32)[:, None] * freqs[None, :]
    cos = jnp.cos(ang)[None, :, None, :].astype(x.dtype)
    sin = jnp.sin(ang)[None, :, None, :].astype(x.dtype)
    x1, x2 = x[..., :half], x[..., half:]
    return jnp.concatenate([x1 * cos - x2 * sin, x2 * cos + x1 * sin], axis=-1)


def axial_rope(x):
    t = jnp.arange(x.shape[1])
    return jnp.concatenate([rope_1d(x[..., :HEAD_DIM // 2], t // GRID_W),
                            rope_1d(x[..., HEAD_DIM // 2:], t % GRID_W)], axis=-1)


def softmax_f32(logits):
    return jax.nn.softmax(logits.astype(jnp.float32), axis=-1)


def project_in(h, w_in):
    b, n = h.shape[:2]
    qa, ka, va, qb, kb, vb, gates = jnp.split(h @ w_in, IN_SPLITS, axis=-1)
    heads = lambda t, nh: t.reshape(b, n, nh, HEAD_DIM)
    return (heads(qa, NA_HEADS), heads(ka, NA_HEADS), heads(va, NA_HEADS),
            heads(qb, SWA_HEADS), heads(kb, SWA_KV_HEADS), heads(vb, SWA_KV_HEADS), gates)


def merge_branches(y_na, y_swa, gates, w_branch_na, w_branch_swa, w_out):
    g_na, g_swa = jnp.split(gates, 2, axis=-1)
    merged = jax.nn.sigmoid(g_na) * (y_na @ w_branch_na) + jax.nn.sigmoid(g_swa) * (y_swa @ w_branch_swa)
    return merged @ w_out


def ctx_attention(q, k, v, sink):
    b, l, kvh, g, d = q.shape
    scale = d ** -0.5
    q_blocks = q.reshape(b, l // BLOCK, BLOCK, kvh, g, d).transpose(1, 0, 2, 3, 4, 5)

    def one_block(q_blk):
        logits = jnp.einsum('bqkgd,blkd->bkgql', q_blk, k).astype(jnp.float32) * scale
        if sink is not None:
            s = jnp.broadcast_to(sink.reshape(kvh, g, 1, 1).astype(jnp.float32), (b, kvh, g, BLOCK, 1))
            logits = jnp.concatenate([logits, s], axis=-1)
        p = softmax_f32(logits)[..., :l].astype(v.dtype)
        return jnp.einsum('bkgql,blkd->bqkgd', p, v)

    out = lax.map(one_block, q_blocks)
    return out.transpose(1, 0, 2, 3, 4, 5).reshape(b, l, kvh * g * d)


def na_latent(q, k, v, ck, cv, rel_bias):
    b, n, h, d = q.shape
    rows = n // GRID_W
    kr = min(NA_ROWS, rows)
    l = ck.shape[1]
    scale = d ** -0.5
    qg = q.reshape(b, rows, GRID_W, h, d)
    kg = k.reshape(b, rows, GRID_W, h, d)
    vg = v.reshape(b, rows, GRID_W, h, d)
    r = np.arange(rows)
    row_start = np.clip(r - kr // 2, 0, rows - kr)
    row_idx = row_start[:, None] + np.arange(kr)[None, :]
    k_blk = kg[:, row_idx]
    v_blk = vg[:, row_idx]
    cq = np.arange(GRID_W)
    col_start = np.clip(cq - NA_COLS // 2, 0, GRID_W - NA_COLS)
    kc = np.arange(GRID_W)
    col_mask = (kc[None, :] >= col_start[:, None]) & (kc[None, :] < col_start[:, None] + NA_COLS)
    dr = row_idx - r[:, None] + (NA_ROWS - 1)
    dc = np.clip(kc[None, :] - cq[:, None], -(NA_COLS - 1), NA_COLS - 1) + (NA_COLS - 1)
    bias = rel_bias[:, dr[:, None, :, None], dc[None, :, None, :]].astype(jnp.float32)
    nb_logits = jnp.einsum('brqhd,brikhd->bhrqik', qg, k_blk).astype(jnp.float32) * scale + bias[None]
    nb_logits = jnp.where(col_mask[None, None, None, :, None, :], nb_logits, NEG_INF)
    nb_logits = nb_logits.reshape(b, h, rows, GRID_W, kr * GRID_W)
    ctx_logits = jnp.einsum('brqhd,blhd->bhrql', qg, ck).astype(jnp.float32) * scale
    p = softmax_f32(jnp.concatenate([nb_logits, ctx_logits], axis=-1))
    p_nb = p[..., :kr * GRID_W].reshape(b, h, rows, GRID_W, kr, GRID_W).astype(v.dtype)
    p_ctx = p[..., kr * GRID_W:].astype(v.dtype)
    out = (jnp.einsum('bhrqik,brikhd->brqhd', p_nb, v_blk)
           + jnp.einsum('bhrql,blhd->brqhd', p_ctx, cv))
    return out.reshape(b, n, h * d)


def swa_latent(q, k, v, ck, cv, sink):
    b, n = q.shape[:2]
    nb = n // BLOCK
    l = ck.shape[1]
    scale = HEAD_DIM ** -0.5
    qb = q.reshape(b, nb, BLOCK, SWA_KV_HEADS, SWA_GROUPS, HEAD_DIM)

    def band(t):
        tp = jnp.pad(t, ((0, 0), (BLOCK, BLOCK), (0, 0), (0, 0))).reshape(b, nb + 2, BLOCK, SWA_KV_HEADS, HEAD_DIM)
        return jnp.concatenate([tp[:, :-2], tp[:, 1:-1], tp[:, 2:]], axis=2)

    k_band, v_band = band(k), band(v)
    qi = np.arange(BLOCK)[:, None]
    kj = np.arange(3 * BLOCK)[None, :]
    key_pos = (np.arange(nb)[:, None, None] - 1) * BLOCK + kj[None]
    mask = (np.abs(kj - BLOCK - qi)[None] <= SWA_WINDOW) & (key_pos >= 0) & (key_pos < n)
    band_logits = jnp.einsum('bnqkgd,bnjkd->bkgnqj', qb, k_band).astype(jnp.float32) * scale
    band_logits = jnp.where(mask, band_logits, NEG_INF)
    ctx_logits = jnp.einsum('bnqkgd,blkd->bkgnql', qb, ck).astype(jnp.float32) * scale
    sink_col = jnp.broadcast_to(sink.reshape(SWA_KV_HEADS, SWA_GROUPS, 1, 1, 1).astype(jnp.float32),
                                (b, SWA_KV_HEADS, SWA_GROUPS, nb, BLOCK, 1))
    p = softmax_f32(jnp.concatenate([band_logits, ctx_logits, sink_col], axis=-1))
    p_band = p[..., :3 * BLOCK].astype(v.dtype)
    p_ctx = p[..., 3 * BLOCK:3 * BLOCK + l].astype(v.dtype)
    out = (jnp.einsum('bkgnqj,bnjkd->bnqkgd', p_band, v_band)
           + jnp.einsum('bkgnql,blkd->bnqkgd', p_ctx, cv))
    return out.reshape(b, n, SWA_HEADS * HEAD_DIM)


def context_mixer(h, w_in, swa_sink, w_branch_na, w_branch_swa, w_out):
    b, l = h.shape[:2]
    qa, ka, va, qb, kb, vb, gates = project_in(h, w_in)
    y_na = ctx_attention(qa[:, :, :, None, :], ka, va, None)
    y_swa = ctx_attention(qb.reshape(b, l, SWA_KV_HEADS, SWA_GROUPS, HEAD_DIM), kb, vb, swa_sink)
    return merge_branches(y_na, y_swa, gates, w_branch_na, w_branch_swa, w_out), (ka, va, kb, vb)


def latent_mixer(h, ck_na, cv_na, ck_swa, cv_swa, w_in, na_rel_bias, swa_sink, w_branch_na, w_branch_swa, w_out):
    qa, ka, va, qb, kb, vb, gates = project_in(h, w_in)
    y_na = na_latent(qa, ka, va, ck_na, cv_na, na_rel_bias)
    y_swa = swa_latent(axial_rope(qb), axial_rope(kb), vb, ck_swa, cv_swa, swa_sink)
    return merge_branches(y_na, y_swa, gates, w_branch_na, w_branch_swa, w_out), ()


def macaron_layer(x, mod, mixer, norm_ffn1, f1_gate, f1_up, f1_down, norm_mix, norm_ffn2, f2_gate, f2_up, f2_down):
    sh1, sc1, gt1, shm, scm, gtm, sh2, sc2, gt2 = (mod[:, i, None, :] for i in range(N_MOD))
    x = x + 0.5 * gt1 * swiglu(modulate(x, norm_ffn1, sh1, sc1), f1_gate, f1_up, f1_down)
    y, aux = mixer(modulate(x, norm_mix, shm, scm))
    x = x + gtm * y
    x = x + 0.5 * gt2 * swiglu(modulate(x, norm_ffn2, sh2, sc2), f2_gate, f2_up, f2_down)
    return x, aux


def setup_inputs(seed: int = 0) -> dict:
    key = jax.random.key(seed)
    ks = jax.random.split(key, 32)
    nrm = lambda k, shape, s: jax.random.normal(k, shape, jnp.float32) * s
    D, F = D_MODEL, FFN_DIM
    return {
        "x_prompt": nrm(ks[0], (BATCH, SEQ, D), 1.0),
        "x_sample": nrm(ks[1], (DEC_BATCH, DEC_SEQ, D), 1.0),
        "cache_na_k": nrm(ks[2], (DEC_BATCH, DEPTH, PAST_LEN, NA_HEADS, HEAD_DIM), 1.0),
        "cache_na_v": nrm(ks[3], (DEC_BATCH, DEPTH, PAST_LEN, NA_HEADS, HEAD_DIM), 1.0),
        "cache_swa_k": nrm(ks[4], (DEC_BATCH, DEPTH, PAST_LEN, SWA_KV_HEADS, HEAD_DIM), 1.0),
        "cache_swa_v": nrm(ks[5], (DEC_BATCH, DEPTH, PAST_LEN, SWA_KV_HEADS, HEAD_DIM), 1.0),
        "c": nrm(ks[6], (DEC_BATCH, D), 1.0),
        "c_ctx": nrm(ks[7], (D,), 1.0),
        "w_ada": nrm(ks[8], (DEPTH, D, N_MOD * D), 0.5 * D ** -0.5),
        "b_ada": nrm(ks[9], (DEPTH, N_MOD * D), 0.01),
        "norm_ffn1": 1.0 + nrm(ks[10], (DEPTH, D), 0.01),
        "ffn1_w_gate": nrm(ks[11], (DEPTH, D, F), D ** -0.5),
        "ffn1_w_up": nrm(ks[12], (DEPTH, D, F), D ** -0.5),
        "ffn1_w_down": nrm(ks[13], (DEPTH, F, D), F ** -0.5),
        "norm_mix": 1.0 + nrm(ks[14], (DEPTH, D), 0.01),
        "w_in": nrm(ks[15], (DEPTH, D, IN_COLS), D ** -0.5),
        "na_rel_bias": nrm(ks[16], (DEPTH, NA_HEADS, 2 * NA_ROWS - 1, 2 * NA_COLS - 1), 0.1),
        "swa_sink": nrm(ks[17], (DEPTH, SWA_HEADS), 0.5),
        "w_branch_na": nrm(ks[18], (DEPTH, NA_WIDTH, D), NA_WIDTH ** -0.5),
        "w_branch_swa": nrm(ks[19], (DEPTH, SWA_Q_WIDTH, D), SWA_Q_WIDTH ** -0.5),
        "w_out": nrm(ks[20], (DEPTH, D, D), D ** -0.5),
        "norm_ffn2": 1.0 + nrm(ks[21], (DEPTH, D), 0.01),
        "ffn2_w_gate": nrm(ks[22], (DEPTH, D, F), D ** -0.5),
        "ffn2_w_up": nrm(ks[23], (DEPTH, D, F), D ** -0.5),
        "ffn2_w_down": nrm(ks[24], (DEPTH, F, D), F ** -0.5),
        "norm_final": 1.0 + nrm(ks[25], (D,), 0.01),
    }


def reference(x_prompt, x_sample, cache_na_k, cache_na_v, cache_swa_k, cache_swa_v, c, c_ctx,
              w_ada, b_ada, norm_ffn1, ffn1_w_gate, ffn1_w_up, ffn1_w_down, norm_mix, w_in,
              na_rel_bias, swa_sink, w_branch_na, w_branch_swa, w_out, norm_ffn2,
              ffn2_w_gate, ffn2_w_up, ffn2_w_down, norm_final):
    x = x_prompt
    new_na_k, new_na_v, new_swa_k, new_swa_v = [], [], [], []
    for layer in range(DEPTH):
        mod = adaln(c_ctx[None, :], w_ada[layer], b_ada[layer])
        mixer = functools.partial(context_mixer, w_in=w_in[layer], swa_sink=swa_sink[layer],
                                  w_branch_na=w_branch_na[layer], w_branch_swa=w_branch_swa[layer],
                                  w_out=w_out[layer])
        x, (ka, va, kb, vb) = macaron_layer(x, mod, mixer, norm_ffn1[layer], ffn1_w_gate[layer],
                                            ffn1_w_up[layer], ffn1_w_down[layer], norm_mix[layer],
                                            norm_ffn2[layer], ffn2_w_gate[layer], ffn2_w_up[layer],
                                            ffn2_w_down[layer])
        new_na_k.append(ka)
        new_na_v.append(va)
        new_swa_k.append(kb)
        new_swa_v.append(vb)
    y_prompt = rmsnorm(x, norm_final)

    x = x_sample
    for layer in range(DEPTH):
        mod = adaln(c, w_ada[layer], b_ada[layer])
        mixer = functools.partial(latent_mixer, ck_na=cache_na_k[:, layer], cv_na=cache_na_v[:, layer],
                                  ck_swa=cache_swa_k[:, layer], cv_swa=cache_swa_v[:, layer],
                                  w_in=w_in[layer], na_rel_bias=na_rel_bias[layer], swa_sink=swa_sink[layer],
                                  w_branch_na=w_branch_na[layer], w_branch_swa=w_branch_swa[layer],
                                  w_out=w_out[layer])
        x, _ = macaron_layer(x, mod, mixer, norm_ffn1[layer], ffn1_w_gate[layer],
                             ffn1_w_up[layer], ffn1_w_down[layer], norm_mix[layer],
                             norm_ffn2[layer], ffn2_w_gate[layer], ffn2_w_up[layer],
                             ffn2_w_down[layer])
    y_sample = rmsnorm(x, norm_final)

    return (y_prompt, y_sample, jnp.stack(new_na_k, axis=1), jnp.stack(new_na_v, axis=1),
            jnp.stack(new_swa_k, axis=1), jnp.stack(new_swa_v, axis=1))
```

```cpp
#include <hip/hip_runtime.h>
#include <hip/hip_cooperative_groups.h>
#include <cstdio>
#include <cstdint>
namespace cg = cooperative_groups;

#ifndef ATTN_DEBUG
#define ATTN_DEBUG 0
#endif
#define ATTN_DEBUG_TOL 2e-5f
#ifndef TIMING_PHASE
#define TIMING_PHASE -1
#endif
#define TIMING_ALPHA 8
#ifndef PROBE_REP
#define PROBE_REP -1
#endif
#ifndef MK_N_LAUNCHES
#define MK_N_LAUNCHES 1
#endif

namespace pg8 {
#define PG8_LAS __attribute__((address_space(3)))
typedef unsigned short bf16_t;
typedef short bf16x8 __attribute__((ext_vector_type(8)));
typedef float f32x4 __attribute__((ext_vector_type(4)));
typedef unsigned u32x4 __attribute__((ext_vector_type(4)));
typedef unsigned u32x2 __attribute__((ext_vector_type(2)));
constexpr int BM = 256, BK = 64, HALF = 128, HTB = HALF * BK * 2  , STAGE_BYTES = 8 * HTB, NXCD = 8, WGM = 8;

__host__ __device__ __forceinline__ int lds_byte(int r, int c) { const int st = (r >> 4) * 2 + (c >> 5), rr = r & 15, cc = c & 31, ob = rr * 64 + cc * 2; return st * 1024 + (ob ^ (((ob >> 9) & 1) << 5)); }
__host__ __device__ __forceinline__ void stage_rc(int b, int& R, int& C) { const int st = b / 1024, sb = b % 1024, swz = sb ^ (((sb >> 9) & 1) << 5); R = (st >> 1) * 16 + swz / 64; C = (st & 1) * 32 + (swz % 64) / 2; }
__host__ __device__ __forceinline__ int perm32(int rho) { const int n = rho >> 4, i = rho & 15; return 8 * (i >> 2) + 4 * n + (i & 3); }

struct Unit { int pm, pn; };
struct Gemm { const bf16_t* A; const bf16_t* Bt; int lda, ldb, M, N, K; };

struct StaticOrder {
    int nM, nN, nwg, G, c;
    __host__ __device__ void init(int M, int N, int G_, int c_) { nM = M / BM; nN = N / BM; nwg = nM * nN; G = G_; c = c_; }
    __host__ __device__ bool next(int i, Unit& u) const {
        const long L = (long)i * G + c; if (L >= nwg) return false;
        int wgid = (int)L; { const int q = nwg / NXCD, r = nwg % NXCD, xcd = wgid % NXCD, off = wgid / NXCD; wgid = (xcd < r ? xcd * (q + 1) : r * (q + 1) + (xcd - r) * q) + off; }
        const int nig = WGM * nN, gid = wgid / nig, fm = gid * WGM, gsz = (nM - fm) < WGM ? (nM - fm) : WGM;
        u.pm = fm + ((wgid % nig) % gsz); u.pn = (wgid % nig) / gsz; return true;
    }
    __device__ __forceinline__ void a_ready(const Unit&) const {}
    __device__ __forceinline__ void done(const Unit&) const {}
};
__device__ __forceinline__ unsigned cvt_pk_bf16(float lo, float hi) { unsigned r; asm volatile("v_cvt_pk_bf16_f32 %0, %1, %2" : "=v"(r) : "v"(lo), "v"(hi)); return r; }

template <class Epi, class Sched, bool ALIGN_EPI = false, bool SP2 = false>
__device__ __forceinline__ void gemm_phase(PG8_LAS unsigned char* lds, const Gemm g, const Sched& S, const Epi& E) {
    const int tid = threadIdx.x, wid = __builtin_amdgcn_readfirstlane(tid >> 6), lane = tid & 63, wr = wid >> 2, wc = wid & 3, fr = lane & 15, fq = lane >> 4;
    const int K = g.K, nt = K / BK;
    unsigned voffA[2], voffB[2];
#pragma unroll
    for (int i = 0; i < 2; ++i) { int R, C; stage_rc(tid * 16 + i * 8192, R, C); const int Rb = Epi::PERM ? ((R & ~31) + perm32(R & 31)) : R;
        voffA[i] = (unsigned)(R * g.lda + C) * 2u; voffB[i] = (unsigned)(Rb * g.ldb + C) * 2u; }
    const size_t kstep = (size_t)(BK * 2);
    const size_t hstepA = (size_t)HALF * g.lda * 2, hstepB = (size_t)HALF * g.ldb * 2;
    const size_t tstepA = 2 * hstepA, tstepB = 2 * hstepB;
    const unsigned ldsw = (unsigned)wid * 1024u;
    const int aoff = lds_byte(wr * 64 + fr, fq * 8), boff = lds_byte(wc * 32 + fr, fq * 8);
#define PG8_SA(b, h) (((b) * 2 + (h)) * HTB)
#define PG8_SB(b, h) ((4 + (b) * 2 + (h)) * HTB)
#define PG8_STAGE(bufoff, gbase, voff) do { _Pragma("unroll") for (int _i = 0; _i < 2; ++_i) \
        __builtin_amdgcn_global_load_lds((const unsigned*)((const char*)(gbase) + (voff)[_i]), (PG8_LAS unsigned*)(lds + (bufoff) + ldsw + _i * 8192), 16, 0, 0); } while (0)
#define PG8_LDA(dst, b, h) do { _Pragma("unroll") for (int m = 0; m < 4; ++m) _Pragma("unroll") for (int k = 0; k < 2; ++k) dst[m][k] = *(const PG8_LAS bf16x8*)(lds + PG8_SA(b, h) + aoff + m * 2048 + k * 1024); } while (0)
#define PG8_LDB(dst, b, h) do { _Pragma("unroll") for (int n = 0; n < 2; ++n) _Pragma("unroll") for (int k = 0; k < 2; ++k) dst[n][k] = *(const PG8_LAS bf16x8*)(lds + PG8_SB(b, h) + boff + n * 2048 + k * 1024); } while (0)
#define PG8_MMA(ai, bj, At, Bt) do { __builtin_amdgcn_s_setprio(1); _Pragma("unroll") for (int m = 0; m < 4; ++m) _Pragma("unroll") for (int n = 0; n < 2; ++n) _Pragma("unroll") for (int k = 0; k < 2; ++k) \
        acc[ai][bj][m][n] = __builtin_amdgcn_mfma_f32_16x16x32_bf16(Bt[n][k], At[m][k], acc[ai][bj][m][n], 0, 0, 0); __builtin_amdgcn_s_setprio(0); } while (0)
#define PG8_WAIT_V(n) asm volatile("s_waitcnt vmcnt(" #n ")" ::: "memory")
#define PG8_WAIT_L(n) asm volatile("s_waitcnt lgkmcnt(" #n ")" ::: "memory")
#define PG8_BAR __builtin_amdgcn_s_barrier()
#define PG8_SCHED __builtin_amdgcn_sched_barrier(0)
    Unit cur, nxt; int ui = 0;
    if (!S.next(0, cur)) return;
    f32x4 acc[2][2][4][2];
#pragma unroll
    for (int a = 0; a < 2; ++a)
#pragma unroll
        for (int b = 0; b < 2; ++b)
#pragma unroll
            for (int m = 0; m < 4; ++m)
#pragma unroll
                for (int n = 0; n < 2; ++n) acc[a][b][m][n] = (f32x4){0.f, 0.f, 0.f, 0.f};
    bf16x8 At[4][2], B0[2][2], B1[2][2];
    const char* cA = (const char*)g.A + (size_t)cur.pm * tstepA; const char* cB = (const char*)g.Bt + (size_t)cur.pn * tstepB;
    S.a_ready(cur);
    if constexpr (SP2) {
        PG8_STAGE(PG8_SB(0, 0), cB, voffB); PG8_STAGE(PG8_SB(0, 1), cB + hstepB, voffB); PG8_STAGE(PG8_SA(0, 0), cA, voffA); PG8_STAGE(PG8_SA(0, 1), cA + hstepA, voffA);
        if (wr == 1) PG8_BAR;
        PG8_WAIT_V(2); PG8_BAR;
        PG8_STAGE(PG8_SB(1, 0), cB + kstep, voffB); PG8_STAGE(PG8_SA(1, 0), cA + kstep, voffA); PG8_STAGE(PG8_SB(1, 1), cB + hstepB + kstep, voffB);
        PG8_WAIT_V(6); PG8_BAR;
    } else {
        PG8_STAGE(PG8_SB(0, 0), cB, voffB); PG8_STAGE(PG8_SA(0, 0), cA, voffA); PG8_STAGE(PG8_SB(0, 1), cB + hstepB, voffB); PG8_STAGE(PG8_SA(0, 1), cA + hstepA, voffA);
        if (wr == 1) PG8_BAR;
        PG8_WAIT_V(4); PG8_BAR;
        PG8_STAGE(PG8_SB(1, 0), cB + kstep, voffB); PG8_STAGE(PG8_SA(1, 0), cA + kstep, voffA); PG8_STAGE(PG8_SB(1, 1), cB + hstepB + kstep, voffB);
        PG8_WAIT_V(6); PG8_BAR;
    }
    for (;;) {
        const bool has_next = S.next(ui + 1, nxt);
        const char* nA = has_next ? (const char*)g.A + (size_t)nxt.pm * tstepA : cA; const char* nB = has_next ? (const char*)g.Bt + (size_t)nxt.pn * tstepB : cB;
        for (int t = 0; t < nt; t += 2) {
            const bool last = (t == nt - 2);
            const char* a1 = cA + (size_t)(t + 1) * kstep;
            const char* a2 = last ? nA : cA + (size_t)(t + 2) * kstep; const char* b2 = last ? nB : cB + (size_t)(t + 2) * kstep;
            const char* a3 = a2 + kstep; const char* b3 = b2 + kstep;
            if (last && has_next) S.a_ready(nxt);
            if constexpr (SP2) {
            PG8_LDB(B0, 0, 0); PG8_LDB(B1, 0, 1); PG8_SCHED; PG8_LDA(At, 0, 0); PG8_STAGE(PG8_SA(1, 1), a1 + hstepA, voffA);
            PG8_WAIT_V(8); PG8_WAIT_L(0); PG8_BAR; PG8_MMA(0, 0, At, B0); PG8_MMA(0, 1, At, B1); PG8_BAR; PG8_SCHED;
            PG8_LDA(At, 0, 1); PG8_STAGE(PG8_SB(0, 0), b2, voffB); PG8_STAGE(PG8_SB(0, 1), b2 + hstepB, voffB); PG8_STAGE(PG8_SA(0, 0), a2, voffA);
            PG8_WAIT_V(8); PG8_WAIT_L(0); PG8_BAR; PG8_MMA(1, 0, At, B0); PG8_MMA(1, 1, At, B1); PG8_BAR; PG8_SCHED;
            PG8_LDB(B0, 1, 0); PG8_LDB(B1, 1, 1); PG8_SCHED; PG8_LDA(At, 1, 0); PG8_STAGE(PG8_SA(0, 1), a2 + hstepA, voffA);
            PG8_WAIT_V(8); PG8_WAIT_L(0); PG8_BAR; PG8_MMA(0, 0, At, B0); PG8_MMA(0, 1, At, B1); PG8_BAR; PG8_SCHED;
            PG8_LDA(At, 1, 1); PG8_STAGE(PG8_SB(1, 0), b3, voffB); PG8_STAGE(PG8_SB(1, 1), b3 + hstepB, voffB); PG8_STAGE(PG8_SA(1, 0), a3, voffA);
            PG8_WAIT_V(8); PG8_WAIT_L(0); PG8_BAR; PG8_MMA(1, 0, At, B0); PG8_MMA(1, 1, At, B1); PG8_BAR; PG8_SCHED;
            } else {
            PG8_LDB(B0, 0, 0); PG8_SCHED; PG8_LDA(At, 0, 0); PG8_STAGE(PG8_SA(1, 1), a1 + hstepA, voffA);
            PG8_WAIT_L(8); PG8_BAR; PG8_WAIT_L(0); PG8_MMA(0, 0, At, B0); PG8_BAR; PG8_SCHED;
            PG8_LDB(B1, 0, 1); PG8_STAGE(PG8_SB(0, 0), b2, voffB);
            PG8_BAR; PG8_WAIT_L(0); PG8_MMA(0, 1, At, B1); PG8_BAR;
            PG8_LDA(At, 0, 1); PG8_STAGE(PG8_SA(0, 0), a2, voffA);
            PG8_BAR; PG8_WAIT_L(0); PG8_MMA(1, 0, At, B0); PG8_BAR; PG8_SCHED;
            PG8_STAGE(PG8_SB(0, 1), b2 + hstepB, voffB);
            PG8_WAIT_V(6); PG8_BAR; PG8_MMA(1, 1, At, B1); PG8_BAR;
            PG8_LDB(B0, 1, 0); PG8_SCHED; PG8_LDA(At, 1, 0); PG8_STAGE(PG8_SA(0, 1), a2 + hstepA, voffA);
            PG8_WAIT_L(8); PG8_BAR; PG8_WAIT_L(0); PG8_MMA(0, 0, At, B0); PG8_BAR; PG8_SCHED;
            PG8_LDB(B1, 1, 1); PG8_STAGE(PG8_SB(1, 0), b3, voffB);
            PG8_BAR; PG8_WAIT_L(0); PG8_MMA(0, 1, At, B1); PG8_BAR;
            PG8_LDA(At, 1, 1); PG8_STAGE(PG8_SA(1, 0), a3, voffA);
            PG8_BAR; PG8_WAIT_L(0); PG8_MMA(1, 0, At, B0); PG8_BAR; PG8_SCHED;
            PG8_STAGE(PG8_SB(1, 1), b3 + hstepB, voffB);
            PG8_WAIT_V(6); PG8_BAR; PG8_MMA(1, 1, At, B1); PG8_BAR;
            }
        }
        if constexpr (ALIGN_EPI) { if (wr == 0) PG8_BAR; }
        if constexpr (!Epi::AFTER_DRAIN) { E(acc, cur, wr, wc, fr, fq); S.done(cur); }
        if (!has_next) break;
#pragma unroll
        for (int a = 0; a < 2; ++a)
#pragma unroll
            for (int b = 0; b < 2; ++b)
#pragma unroll
                for (int m = 0; m < 4; ++m)
#pragma unroll
                    for (int n = 0; n < 2; ++n) acc[a][b][m][n] = (f32x4){0.f, 0.f, 0.f, 0.f};
        cur = nxt; cA = nA; cB = nB; ++ui;
        if constexpr (ALIGN_EPI) { if (wr == 1) PG8_BAR; }
    }
    PG8_WAIT_V(0);
    if constexpr (!ALIGN_EPI) { if (wr == 0) PG8_BAR; }
    PG8_BAR;
    if constexpr (Epi::AFTER_DRAIN) { E.fused(acc, cur, wr, wc, fr, fq, lds, wid, lane); S.done(cur); }
#undef PG8_SA
#undef PG8_SB
#undef PG8_STAGE
#undef PG8_LDA
#undef PG8_LDB
#undef PG8_MMA
#undef PG8_WAIT_V
#undef PG8_WAIT_L
#undef PG8_BAR
#undef PG8_SCHED
}
}

using pg8::bf16_t; using pg8::f32x4; using pg8::u32x4; using pg8::u32x2; using pg8::Unit; using pg8::cvt_pk_bf16;
#define LAS __attribute__((address_space(3)))

constexpr int D = 1024, FF = 2816, NIN = 4352;
constexpr int M_CTX = 4096, M_LAT = 16384, M = M_CTX + M_LAT;
constexpr int LAT_N = 2048, CTX_L = 256, PAST = 256, GRID_W = 64;
constexpr int NCOND = 9, MODW = 9 * D;
constexpr float EPS = 1e-6f, LOG2E = 1.4426950408889634f, QSCALE = 0.125f * LOG2E;
constexpr int NWAVES = 8;

constexpr size_t OUT_Y = 0, OUT_NAK = (size_t)M * D, OUT_NAV = OUT_NAK + (size_t)M_CTX * 512, OUT_SWK = OUT_NAV + (size_t)M_CTX * 512, OUT_SWV = OUT_SWK + (size_t)M_CTX * 128, OUT_END = OUT_SWV + (size_t)M_CTX * 128;

constexpr size_t MiB = 1u << 20;
constexpr size_t WS_CTL = 0, CTL_ZERO_BYTES = 1 * MiB;
constexpr size_t WS_MOD = 1 * MiB;
constexpr size_t WS_ROPE = 1 * MiB + 512 * 1024;
constexpr size_t WS_GS = 2 * MiB;
constexpr size_t WS_B2IN = 2 * MiB + 256 * 1024;
constexpr size_t WS_B2GU = 2 * MiB + 512 * 1024;
constexpr size_t WS_SS = 3 * MiB;
constexpr size_t WS_WGU1 = 8 * MiB;
constexpr size_t WS_WD1 = 19 * MiB;
constexpr size_t WS_WIN = WS_WD1 + 5 * MiB + 512 * 1024;
constexpr size_t WS_WB = 33 * MiB;
constexpr size_t WS_WOUT = 35 * MiB;
constexpr size_t WS_WGU2 = 37 * MiB, WS_WD2 = 48 * MiB;
constexpr size_t WS_CKNA = 54 * MiB, WS_CVNA = 56 * MiB, WS_CKSWA = 58 * MiB, WS_CVSWA = 58 * MiB + 512 * 1024;
constexpr size_t WS_H = 60 * MiB;
constexpr size_t WS_H2 = 100 * MiB;
constexpr size_t WS_R = 140 * MiB;
constexpr size_t WS_ACT = WS_R;
constexpr size_t WS_QAB = WS_R, WS_KA = WS_R + 40 * MiB, WS_VA = WS_R + 60 * MiB, WS_KB = WS_R + 80 * MiB, WS_VB = WS_R + 85 * MiB;
constexpr size_t WS_SGNA = WS_R + 90 * MiB, WS_SGSWA = WS_R + 130 * MiB;
constexpr size_t WS_TMP = WS_KA;
constexpr size_t WS_END = WS_R + 170 * MiB;
static_assert(WS_WIN + (size_t)NIN * D * 2 <= WS_WB && WS_WD2 + (size_t)D * FF * 2 <= WS_CKNA && WS_SS + (size_t)2 * M * 16 * 4 <= WS_WGU1 && WS_B2GU + 9 * 5632 * 4 <= WS_SS, "ws map");

constexpr int RING_BYTES = 131072, LDSCTL_OFF = RING_BYTES, MISC_OFF = LDSCTL_OFF + 320, LDS_BYTES = 147456;
constexpr int CW_BAR = 4096;

__device__ __forceinline__ float bf2f(unsigned short u) { return __uint_as_float((unsigned)u << 16); }
__device__ __forceinline__ unsigned f2bf(float f) { unsigned u = __float_as_uint(f); return (u + 0x7fffu + ((u >> 16) & 1u)) >> 16; }
__device__ __forceinline__ unsigned pk2(float lo, float hi) { return f2bf(lo) | (f2bf(hi) << 16); }
__device__ __forceinline__ float wave_sum(float v) {
#pragma unroll
    for (int o = 1; o < 64; o <<= 1) v += __shfl_xor(v, o);
    return v;
}
__device__ __forceinline__ int cond_of_tile(int pm) { return pm < 16 ? 0 : 1 + ((pm - 16) >> 3); }
__device__ __forceinline__ int cond_of_row(int row) { return row < M_CTX ? 0 : 1 + ((row - M_CTX) >> 11); }
__device__ __forceinline__ float sigmoidf_(float x) { return 1.0f / (1.0f + __expf(-x)); }


__device__ __forceinline__ float row_rstd(const float* SS, int row) {
    const f32x4* p = (const f32x4*)(SS + (size_t)row * 16); const f32x4 a = p[0], b = p[1], c = p[2], d = p[3];
    const float s = ((a.x + a.y) + (a.z + a.w)) + ((b.x + b.y) + (b.z + b.w)) + ((c.x + c.y) + (c.z + c.w)) + ((d.x + d.y) + (d.z + d.w));
    return 1.0f / sqrtf(s * (1.0f / D) + EPS);
}
template <bool NORM> struct EpiSwiGLU {
    static constexpr bool PERM = true, AFTER_DRAIN = false;
    unsigned char* wsb;
    __device__ __forceinline__ void operator()(const f32x4 (&acc)[2][2][4][2], const Unit& u, int wr, int wc, int fr, int fq) const {
        bf16_t* O = (bf16_t*)(wsb + WS_ACT); const float* SS = (const float*)(wsb + WS_SS) + (size_t)M * 16; const float* B2 = (const float*)(wsb + WS_B2GU);
        const int row0 = u.pm * 256 + wr * 64 + fr, col0 = u.pn * 128 + wc * 32 + 8 * fq;
        f32x4 bg[2], bu[2];
        if (NORM) { const float* b2 = B2 + (size_t)cond_of_tile(u.pm) * (2 * FF) + u.pn * 256 + wc * 32 + 8 * fq;
            bg[0] = *(const f32x4*)(b2); bg[1] = *(const f32x4*)(b2 + 4); bu[0] = *(const f32x4*)(b2 + 128); bu[1] = *(const f32x4*)(b2 + 132); }
#pragma unroll
        for (int ai = 0; ai < 2; ++ai)
#pragma unroll
            for (int m = 0; m < 4; ++m) {
                const int row = row0 + ai * 128 + m * 16;
                bf16_t* rowp = O + (size_t)row * FF + col0;
                float rs = 1.0f; if (NORM) rs = row_rstd(SS, row);
                float o[8];
#pragma unroll
                for (int n = 0; n < 2; ++n)
#pragma unroll
                    for (int j = 0; j < 4; ++j) { float g = acc[ai][0][m][n][j], up = acc[ai][1][m][n][j]; if (NORM) { g = g * rs + bg[n][j]; up = up * rs + bu[n][j]; } o[4 * n + j] = g * sigmoidf_(g) * up; }
                u32x4 w; w.x = cvt_pk_bf16(o[0], o[1]); w.y = cvt_pk_bf16(o[2], o[3]); w.z = cvt_pk_bf16(o[4], o[5]); w.w = cvt_pk_bf16(o[6], o[7]);
                *(u32x4*)rowp = w;
            }
    }
};

template <int STAGE> struct EpiResid {
    static constexpr bool PERM = false, AFTER_DRAIN = false;
    const float* xp; const float* xs; float* out; unsigned char* wsb;
    __device__ __forceinline__ void operator()(const f32x4 (&acc)[2][2][4][2], const Unit& u, int wr, int wc, int fr, int fq) const {
        constexpr int gate_idx = STAGE == 0 ? 2 : STAGE == 1 ? 5 : 8; constexpr float coef = STAGE == 1 ? 1.0f : 0.5f; constexpr bool NEXT = STAGE < 2;
        const float* base_ctx = STAGE == 0 ? xp : out; const float* base_lat = STAGE == 0 ? xs : out + (size_t)M_CTX * D;
        const float* mod = (const float*)(wsb + WS_MOD); bf16_t* HN = NEXT ? (bf16_t*)(wsb + WS_H2) : nullptr;
        const float* gs = (const float*)(wsb + WS_GS) + (STAGE == 1 ? NCOND * D : 0); float* SS = (float*)(wsb + WS_SS) + (STAGE == 1 ? (size_t)M * 16 : 0);
        const int row0 = u.pm * 256 + wr * 64 + fr, col0 = u.pn * 256 + wc * 32 + 4 * fq, cnd = cond_of_tile(u.pm);
        const float* gate = mod + (size_t)cnd * MODW + gate_idx * D + col0;
        f32x4 gv[2][2], sv[2][2];
#pragma unroll
        for (int bj = 0; bj < 2; ++bj)
#pragma unroll
            for (int n = 0; n < 2; ++n) { gv[bj][n] = *(const f32x4*)(gate + bj * 128 + n * 16) * coef; if (HN) sv[bj][n] = *(const f32x4*)(gs + (size_t)cnd * D + col0 + bj * 128 + n * 16); }
#pragma unroll
        for (int ai = 0; ai < 2; ++ai)
#pragma unroll
            for (int m = 0; m < 4; ++m) {
                const int row = row0 + ai * 128 + m * 16;
                const float* bp = (row < M_CTX ? base_ctx + (size_t)row * D : base_lat + (size_t)(row - M_CTX) * D) + col0;
                float* op = out + (size_t)row * D + col0;
                float s2 = 0.f;
#pragma unroll
                for (int bj = 0; bj < 2; ++bj)
#pragma unroll
                    for (int n = 0; n < 2; ++n) { const f32x4 b = *(const f32x4*)(bp + bj * 128 + n * 16); const f32x4 v = b + gv[bj][n] * acc[ai][bj][m][n]; *(f32x4*)(op + bj * 128 + n * 16) = v;
                        if (HN) { s2 += (v.x * v.x + v.y * v.y) + (v.z * v.z + v.w * v.w); const f32x4 h = v * sv[bj][n]; u32x2 w; w.x = cvt_pk_bf16(h.x, h.y); w.y = cvt_pk_bf16(h.z, h.w);
                                  *(u32x2*)(HN + (size_t)row * D + col0 + bj * 128 + n * 16) = w; } }
                if (HN) { s2 += __shfl_xor(s2, 16); s2 += __shfl_xor(s2, 32); if (fq == 0) SS[(size_t)row * 16 + u.pn * 4 + wc] = s2; }
            }
    }
};

struct EpiIn {
    static constexpr bool PERM = false, AFTER_DRAIN = false;
    unsigned char* wsb; float* outp;
    template <int MODE> __device__ __forceinline__ void half(const f32x4 (&acc)[2][2][4][2], const float (&rs)[2][4], int pn, int bj, int pm, int wr, int wc, int fr, int fq, bf16_t* dst, int ld, int dcol, float* fdst, float qs = 1.0f) const {
        const int row0 = pm * 256 + wr * 64 + fr, c0 = dcol + wc * 32 + 4 * fq;
        const bool lat = pm >= 16;
        const float* b2 = (const float*)(wsb + WS_B2IN) + (size_t)cond_of_tile(pm) * NIN + pn * 256 + bj * 128 + wc * 32 + 4 * fq; const float2* rope = (const float2*)(wsb + WS_ROPE);
        const f32x4 b2a = *(const f32x4*)b2, b2b = *(const f32x4*)(b2 + 16);
#pragma unroll
        for (int ai = 0; ai < 2; ++ai)
#pragma unroll
            for (int m = 0; m < 4; ++m) {
                const int row = row0 + ai * 128 + m * 16;
                f32x4 v0 = acc[ai][bj][m][0] * rs[ai][m] + b2a, v1 = acc[ai][bj][m][1] * rs[ai][m] + b2b;
                if (fdst && !lat) { *(f32x4*)(fdst + (size_t)row * ld + c0) = v0; *(f32x4*)(fdst + (size_t)row * ld + c0 + 16) = v1; }
                if (MODE == 1 && lat) {
                    const int t = (row - M_CTX) & (LAT_N - 1), pos = (wc & 1) ? (t & 63) : (t >> 6);
                    const float2* cs = rope + pos * 16 + 4 * fq;
                    f32x4 a, b;
#pragma unroll
                    for (int j = 0; j < 4; ++j) { const float2 t2 = cs[j]; a[j] = v0[j] * t2.x - v1[j] * t2.y; b[j] = v1[j] * t2.x + v0[j] * t2.y; }
                    v0 = a; v1 = b;
                }
                if (MODE == 2) {
#pragma unroll
                    for (int j = 0; j < 4; ++j) { v0[j] = sigmoidf_(v0[j]); v1[j] = sigmoidf_(v1[j]); }
                }
                v0 = v0 * qs; v1 = v1 * qs;
                u32x2 w0, w1; w0.x = cvt_pk_bf16(v0[0], v0[1]); w0.y = cvt_pk_bf16(v0[2], v0[3]); w1.x = cvt_pk_bf16(v1[0], v1[1]); w1.y = cvt_pk_bf16(v1[2], v1[3]);
                *(u32x2*)(dst + (size_t)row * ld + c0) = w0; *(u32x2*)(dst + (size_t)row * ld + c0 + 16) = w1;
            }
    }
    __device__ __forceinline__ void operator()(const f32x4 (&acc)[2][2][4][2], const Unit& u, int wr, int wc, int fr, int fq) const {
        const int pn = u.pn, pm = u.pm;
        bf16_t* QAB = (bf16_t*)(wsb + WS_QAB); bf16_t* KA = (bf16_t*)(wsb + WS_KA); bf16_t* VA = (bf16_t*)(wsb + WS_VA); bf16_t* KB = (bf16_t*)(wsb + WS_KB); bf16_t* VB = (bf16_t*)(wsb + WS_VB);
        bf16_t* SGNA = (bf16_t*)(wsb + WS_SGNA); bf16_t* SGSWA = (bf16_t*)(wsb + WS_SGSWA); const float* SS = (const float*)(wsb + WS_SS);
        float* o_nak = outp + OUT_NAK; float* o_nav = outp + OUT_NAV; float* o_swk = outp + OUT_SWK; float* o_swv = outp + OUT_SWV;
        float rs[2][4];
#pragma unroll
        for (int ai = 0; ai < 2; ++ai)
#pragma unroll
            for (int m = 0; m < 4; ++m) rs[ai][m] = row_rstd(SS, pm * 256 + wr * 64 + fr + ai * 128 + m * 16);
#define HALF_(MODE, bj, dst, ld, dcol, fdst, qs) half<MODE>(acc, rs, pn, bj, pm, wr, wc, fr, fq, dst, ld, dcol, fdst, qs)
        if (pn < 2)       { HALF_(0, 0, QAB, 1024, 256 * pn, nullptr, QSCALE);             HALF_(0, 1, QAB, 1024, 256 * pn + 128, nullptr, QSCALE); }
        else if (pn < 4)  { HALF_(0, 0, KA, 512, 256 * (pn - 2), o_nak, 1.0f);             HALF_(0, 1, KA, 512, 256 * (pn - 2) + 128, o_nak, 1.0f); }
        else if (pn < 6)  { HALF_(0, 0, VA, 512, 256 * (pn - 4), o_nav, 1.0f);             HALF_(0, 1, VA, 512, 256 * (pn - 4) + 128, o_nav, 1.0f); }
        else if (pn < 8)  { HALF_(1, 0, QAB, 1024, 512 + 256 * (pn - 6), nullptr, QSCALE); HALF_(1, 1, QAB, 1024, 512 + 256 * (pn - 6) + 128, nullptr, QSCALE); }
        else if (pn == 8) { HALF_(1, 0, KB, 128, 0, o_swk, 1.0f);                          HALF_(0, 1, VB, 128, 0, o_swv, 1.0f); }
        else if (pn < 13) { HALF_(2, 0, SGNA, 1024, 256 * (pn - 9), nullptr, 1.0f);        HALF_(2, 1, SGNA, 1024, 256 * (pn - 9) + 128, nullptr, 1.0f); }
        else              { HALF_(2, 0, SGSWA, 1024, 256 * (pn - 13), nullptr, 1.0f);      HALF_(2, 1, SGSWA, 1024, 256 * (pn - 13) + 128, nullptr, 1.0f); }
#undef HALF_
    }
};

template <bool SECOND> struct EpiMerge {
    static constexpr bool PERM = true, AFTER_DRAIN = false;
    unsigned char* wsb;
    __device__ __forceinline__ void operator()(const f32x4 (&acc)[2][2][4][2], const Unit& u, int wr, int wc, int fr, int fq) const {
        const bf16_t* SG = (const bf16_t*)(wsb + (SECOND ? WS_SGSWA : WS_SGNA)); const bf16_t* TMPIN = (const bf16_t*)(wsb + WS_TMP); bf16_t* O = (bf16_t*)(wsb + (SECOND ? WS_H : WS_TMP));
        const int row0 = u.pm * 256 + wr * 64 + fr, col0 = u.pn * 256 + wc * 32 + 8 * fq;
#pragma unroll
        for (int ai = 0; ai < 2; ++ai)
#pragma unroll
            for (int m = 0; m < 4; ++m)
#pragma unroll
                for (int bj = 0; bj < 2; ++bj) {
                    const size_t off = (size_t)(row0 + ai * 128 + m * 16) * D + col0 + bj * 128;
                    const u32x4 sg = *(const u32x4*)(SG + off);
                    u32x4 tp = (u32x4){0u, 0u, 0u, 0u}; if (SECOND) tp = *(const u32x4*)(TMPIN + off);
                    float o[8];
#pragma unroll
                    for (int n = 0; n < 2; ++n)
#pragma unroll
                        for (int j = 0; j < 4; ++j) {
                            const int e = 4 * n + j; const unsigned sw = sg[e >> 1], tw = tp[e >> 1];
                            const float s = (e & 1) ? __uint_as_float(sw & 0xffff0000u) : __uint_as_float(sw << 16);
                            const float t = (e & 1) ? __uint_as_float(tw & 0xffff0000u) : __uint_as_float(tw << 16);
                            o[e] = t + s * acc[ai][bj][m][n][j];
                        }
                    u32x4 w; w.x = cvt_pk_bf16(o[0], o[1]); w.y = cvt_pk_bf16(o[2], o[3]); w.z = cvt_pk_bf16(o[4], o[5]); w.w = cvt_pk_bf16(o[6], o[7]);
                    *(u32x4*)(O + off) = w;
                }
    }
};

struct Ctx {
    LAS unsigned char* lds; int tid, lane, wave, vcu, G;
};

constexpr int TR_ROWB = 144;
__device__ __forceinline__ void transpose_item(const float* W, int N, bf16_t* WT, int ldt, int koff, int drow0, LAS unsigned char* scr, int kb, int nb, int lane) {
    const int k0 = 64 * kb, n0 = 64 * nb, kr = lane >> 4, nq = lane & 15;
    const float* src = W + (size_t)(k0 + 16 * kr) * N + n0 + 4 * nq;
    f32x4 v[16];
#pragma unroll
    for (int i = 0; i < 16; ++i) v[i] = *(const f32x4*)(src + (size_t)i * N);
#pragma unroll
    for (int e = 0; e < 4; ++e) {
        u32x4 lo, hi;
        lo.x = cvt_pk_bf16(v[0][e], v[1][e]); lo.y = cvt_pk_bf16(v[2][e], v[3][e]); lo.z = cvt_pk_bf16(v[4][e], v[5][e]); lo.w = cvt_pk_bf16(v[6][e], v[7][e]);
        hi.x = cvt_pk_bf16(v[8][e], v[9][e]); hi.y = cvt_pk_bf16(v[10][e], v[11][e]); hi.z = cvt_pk_bf16(v[12][e], v[13][e]); hi.w = cvt_pk_bf16(v[14][e], v[15][e]);
        LAS unsigned char* p = scr + (4 * nq + e) * TR_ROWB + 32 * kr;
        *(LAS u32x4*)p = lo; *(LAS u32x4*)(p + 16) = hi;
    }
    asm volatile("s_waitcnt lgkmcnt(0)" ::: "memory");
#pragma unroll
    for (int j = 0; j < 8; ++j) { const int row = 8 * j + (lane >> 3), ch = lane & 7;
        const u32x4 o = *(const LAS u32x4*)(scr + row * TR_ROWB + 16 * ch);
        *(u32x4*)(WT + (size_t)(drow0 + row) * ldt + koff + k0 + 8 * ch) = o; }
    asm volatile("s_waitcnt lgkmcnt(0)" ::: "memory");
}
__device__ __forceinline__ void tr_plain(const float* W, int K, int N, bf16_t* WT, int ldt, int koff, LAS unsigned char* scr, int item, int lane) {
    const int nblk = N / 64, kb = item / nblk, nb = item % nblk; (void)K;
    transpose_item(W, N, WT, ldt, koff, 64 * nb, scr, kb, nb, lane);
}
__device__ __forceinline__ void tr_gu(const float* W, bf16_t* WT, int up, LAS unsigned char* scr, int item, int lane) {
    const int nblk = FF / 64, kb = item / nblk, nb = item % nblk, n0 = 64 * nb;
    transpose_item(W, FF, WT, D, 0, (n0 >> 7) * 256 + (n0 & 127) + up * 128, scr, kb, nb, lane);
}
constexpr int I_GU = (D / 64) * (FF / 64), I_DN = (FF / 64) * (D / 64), I_IN = (D / 64) * (NIN / 64), I_BR = (512 / 64) * (D / 64), I_OUT = (D / 64) * (D / 64);
constexpr int I_ALL = 2 * (2 * I_GU + I_DN) + I_IN + 2 * I_BR + I_OUT;

template <bool FINAL> __device__ __forceinline__ void norm_rows(const float* xp, const float* xs, void* outp, const float* g, const float* mod, int sc_idx, int sh_idx, int row0, int stride, int lane) {
    f32x4 v[4], nv[4];
    if (row0 < M) { const f32x4* xr = (const f32x4*)(row0 < M_CTX ? xp + (size_t)row0 * D : xs + (size_t)(row0 - M_CTX) * D) + lane;
#pragma unroll
        for (int j = 0; j < 4; ++j) v[j] = xr[64 * j]; }
    for (int row = row0; row < M; row += stride) {
        const int nrow = row + stride;
        if (nrow < M) { const f32x4* xr = (const f32x4*)(nrow < M_CTX ? xp + (size_t)nrow * D : xs + (size_t)(nrow - M_CTX) * D) + lane;
#pragma unroll
            for (int j = 0; j < 4; ++j) nv[j] = xr[64 * j]; }
        float s2 = 0.f;
#pragma unroll
        for (int j = 0; j < 4; ++j) s2 += (v[j].x * v[j].x + v[j].y * v[j].y) + (v[j].z * v[j].z + v[j].w * v[j].w);
        const float rstd = 1.0f / sqrtf(wave_sum(s2) * (1.0f / D) + EPS);
        const float* md = mod + (size_t)cond_of_row(row) * MODW;
#pragma unroll
        for (int j = 0; j < 4; ++j) {
            const f32x4 gv = ((const f32x4*)g)[64 * j + lane];
            f32x4 o = v[j] * rstd * gv;
            if (FINAL) { ((f32x4*)outp)[(size_t)row * (D / 4) + 64 * j + lane] = o; }
            else {
                const f32x4 scv = ((const f32x4*)(md + sc_idx * D))[64 * j + lane], shv = ((const f32x4*)(md + sh_idx * D))[64 * j + lane];
                o = o * (scv + 1.0f) + shv;
                u32x2 w; w.x = cvt_pk_bf16(o.x, o.y); w.y = cvt_pk_bf16(o.z, o.w);
                ((u32x2*)outp)[(size_t)row * (D / 4) + 64 * j + lane] = w;
            }
        }
#pragma unroll
        for (int j = 0; j < 4; ++j) v[j] = nv[j];
    }
}

struct AttnBufs { bf16_t *OB; bf16_t *QAB; const bf16_t *KA, *VA, *KB, *VB, *CKNA, *CVNA, *CKSWA, *CVSWA; const float* relb; const float* sink; };

#define ATT_STEP(KP, VP, BIAS2, VALID) do { if (VALID) { \
        const u32x4* kp_ = (const u32x4*)(KP); float s_ = (BIAS2); \
        _Pragma("unroll") for (int c_ = 0; c_ < 8; ++c_) { const u32x4 kk_ = kp_[c_]; \
            _Pragma("unroll") for (int e_ = 0; e_ < 4; ++e_) { s_ += q[8 * c_ + 2 * e_] * __uint_as_float(kk_[e_] << 16) + q[8 * c_ + 2 * e_ + 1] * __uint_as_float(kk_[e_] & 0xffff0000u); } } \
        if (s_ > mx) { const float al_ = exp2f(mx - s_); l *= al_; _Pragma("unroll") for (int d_ = 0; d_ < 64; ++d_) o[d_] *= al_; mx = s_; } \
        const float p_ = exp2f(s_ - mx); l += p_; \
        const u32x4* vp_ = (const u32x4*)(VP); \
        _Pragma("unroll") for (int c_ = 0; c_ < 8; ++c_) { const u32x4 vv_ = vp_[c_]; \
            _Pragma("unroll") for (int e_ = 0; e_ < 4; ++e_) { o[8 * c_ + 2 * e_] += p_ * __uint_as_float(vv_[e_] << 16); o[8 * c_ + 2 * e_ + 1] += p_ * __uint_as_float(vv_[e_] & 0xffff0000u); } } \
    } } while (0)

__device__ __forceinline__ void attn_naive_item(const AttnBufs& A, int kind, int b, int head, int chunk, int lane) {
    const bool lat = kind >= 2, swa = kind & 1;
    const int t = chunk * 64 + lane;
    const int row = lat ? M_CTX + b * LAT_N + t : b * CTX_L + t;
    const int qcol = swa ? 512 + head * 64 : head * 64;
    bf16_t* qp = A.QAB + (size_t)row * 1024 + qcol;
    float q[64], o[64];
#pragma unroll
    for (int c = 0; c < 8; ++c) { const u32x4 w = ((const u32x4*)qp)[c];
#pragma unroll
        for (int e = 0; e < 4; ++e) { q[8 * c + 2 * e] = __uint_as_float(w[e] << 16); q[8 * c + 2 * e + 1] = __uint_as_float(w[e] & 0xffff0000u); } }
#pragma unroll
    for (int d = 0; d < 64; ++d) o[d] = 0.f;
    float mx = -1e30f, l = 0.f;
    if (swa) { mx = A.sink[head] * LOG2E; l = 1.f; }
    const int kvh = head >> 2;
    if (!lat) {
        const bf16_t* kb_ = swa ? A.KB + (size_t)(b * CTX_L) * 128 + kvh * 64 : A.KA + (size_t)(b * CTX_L) * 512 + head * 64;
        const bf16_t* vb_ = swa ? A.VB + (size_t)(b * CTX_L) * 128 + kvh * 64 : A.VA + (size_t)(b * CTX_L) * 512 + head * 64;
        const int ld = swa ? 128 : 512;
        for (int j = 0; j < CTX_L; ++j) ATT_STEP(kb_ + (size_t)j * ld, vb_ + (size_t)j * ld, 0.f, true);
    } else if (!swa) {
        const int r = t >> 6, c = t & 63;
        const int rs = min(max(r - 4, 0), 24), cs = min(max(c - 8, 0), 48);
        const bf16_t* kb_ = A.KA + (size_t)(M_CTX + b * LAT_N) * 512 + head * 64;
        const bf16_t* vb_ = A.VA + (size_t)(M_CTX + b * LAT_N) * 512 + head * 64;
        const float* rb = A.relb + head * (15 * 31);
        for (int i = 0; i < 8; ++i)
            for (int j = 0; j < 16; ++j) {
                const int kt = (rs + i) * 64 + cs + j;
                const float bias = rb[(rs + i - r + 7) * 31 + (cs + j - c + 15)] * LOG2E;
                ATT_STEP(kb_ + (size_t)kt * 512, vb_ + (size_t)kt * 512, bias, true);
            }
        const bf16_t* ck = A.CKNA + (size_t)(b * PAST) * 512 + head * 64; const bf16_t* cv = A.CVNA + (size_t)(b * PAST) * 512 + head * 64;
        for (int j = 0; j < PAST; ++j) ATT_STEP(ck + (size_t)j * 512, cv + (size_t)j * 512, 0.f, true);
    } else {
        const bf16_t* kb_ = A.KB + (size_t)(M_CTX + b * LAT_N) * 128 + kvh * 64;
        const bf16_t* vb_ = A.VB + (size_t)(M_CTX + b * LAT_N) * 128 + kvh * 64;
        const int t0 = chunk * 64, jlo = max(0, t0 - 128), jhi = min(LAT_N - 1, t0 + 63 + 128);
        for (int j = jlo; j <= jhi; ++j) { const int dj = j - t; ATT_STEP(kb_ + (size_t)j * 128, vb_ + (size_t)j * 128, 0.f, (dj <= 128 && dj >= -128)); }
        const bf16_t* ck = A.CKSWA + (size_t)(b * PAST) * 128 + kvh * 64; const bf16_t* cv = A.CVSWA + (size_t)(b * PAST) * 128 + kvh * 64;
        for (int j = 0; j < PAST; ++j) ATT_STEP(ck + (size_t)j * 128, cv + (size_t)j * 128, 0.f, true);
    }
    const float rl = 1.0f / l;
#pragma unroll
    for (int c = 0; c < 8; ++c) { u32x4 w;
#pragma unroll
        for (int e = 0; e < 4; ++e) w[e] = pk2(o[8 * c + 2 * e] * rl, o[8 * c + 2 * e + 1] * rl);
        ((u32x4*)qp)[c] = w; }
}
__device__ __forceinline__ void attn_naive_phase(const Ctx& F, const AttnBufs& A) {
    const int gw = F.vcu * NWAVES + F.wave, NGW = F.G * NWAVES;
    for (int it = gw; it < 4096 + 1024; it += NGW) {
        if (it < 4096) { const int chunk = it & 31, hh = (it >> 5) & 15, b = it >> 9; attn_naive_item(A, 2 + (hh >> 3), b, hh & 7, chunk, F.lane); }
        else { const int r = it - 4096, chunk = r & 3, hh = (r >> 2) & 15, b = r >> 6; attn_naive_item(A, hh >> 3, b, hh & 7, chunk, F.lane); }
    }
}


namespace att {
typedef short bf16x8 __attribute__((ext_vector_type(8)));
typedef short s16x4 __attribute__((ext_vector_type(4)));
typedef float f32x16 __attribute__((ext_vector_type(16)));
typedef float f32x2_t __attribute__((ext_vector_type(2))); typedef __bf16 bf16x2_t __attribute__((ext_vector_type(2)));
constexpr int A_K = 0, A_V = 16384, A_WSF = 32768, A_OST = 34816, A_TB = 67584, TB_ROW = 132, TB_FLOATS = 4 * 15 * TB_ROW;
static_assert(A_TB + TB_FLOATS * 4 <= RING_BYTES, "attention LDS map");
__device__ __forceinline__ int crow(int r, int hi) { return (r & 3) + 8 * (r >> 2) + 4 * hi; }
__device__ __forceinline__ unsigned cvtpk_s(float lo, float hi) { f32x2_t v = {lo, hi}; bf16x2_t b = __builtin_convertvector(v, bf16x2_t); return __builtin_bit_cast(unsigned, b); }
__device__ __forceinline__ s16x4 vtr(const LAS unsigned char* p) { typedef short v4i16_t __attribute__((ext_vector_type(4))); return __builtin_bit_cast(s16x4, __builtin_amdgcn_ds_read_tr16_b64_v4i16((LAS v4i16_t*)p)); }
__device__ __forceinline__ float halves_max(float m) { auto rr = __builtin_amdgcn_permlane32_swap(__float_as_uint(m), __float_as_uint(m), false, false); return fmaxf(__uint_as_float(rr[0]), __uint_as_float(rr[1])); }
__device__ __forceinline__ float halves_sum(float m) { auto rr = __builtin_amdgcn_permlane32_swap(__float_as_uint(m), __float_as_uint(m), false, false); return __uint_as_float(rr[0]) + __uint_as_float(rr[1]); }

template <int KIND>
__device__ __forceinline__ void attn_unit(LAS unsigned char* lds, const AttnBufs& A, int ub, int uh, int ux, int lane, int wid) {
    constexpr bool LAT = KIND >= 2, SWA = (KIND & 1) != 0, NA_LAT = KIND == 2, SWA_LAT = KIND == 3;
    const int r32 = lane & 31, hi = lane >> 5;
    int qrow0, qcol, ldk, NB, NT; const bf16_t *Kb, *Vb, *Kc, *Vc;
    int wlo = 0, whi = 1 << 30, dr0 = 0, cq = 0, qpos0 = 0, kt00 = 0, head = uh;
    if (KIND == 0) { qrow0 = ub * CTX_L + 32 * wid; qcol = uh * 64; ldk = 512; NB = 4; NT = 4;
        Kb = A.KA + (size_t)(ub * CTX_L) * 512 + uh * 64; Vb = A.VA + (size_t)(ub * CTX_L) * 512 + uh * 64; Kc = Kb; Vc = Vb; }
    else if (KIND == 1) { qrow0 = ub * CTX_L + 32 * wid; qcol = 512 + uh * 64; ldk = 128; NB = 4; NT = 4;
        Kb = A.KB + (size_t)(ub * CTX_L) * 128 + (uh >> 2) * 64; Vb = A.VB + (size_t)(ub * CTX_L) * 128 + (uh >> 2) * 64; Kc = Kb; Vc = Vb; }
    else if (KIND == 2) {
        const int r0 = 4 * ux, rw = r0 + (wid >> 1), c0 = 32 * (wid & 1);
        const int kr_lo = min(max(r0 - 4, 0), 24), kr_hi = min(max(r0 + 3 - 4, 0), 24) + 7, rs_w = min(max(rw - 4, 0), 24);
        qrow0 = M_CTX + ub * LAT_N + rw * 64 + c0; qcol = uh * 64; ldk = 512; NB = kr_hi - kr_lo + 1; NT = NB + 4;
        wlo = rs_w - kr_lo; whi = wlo + 7; dr0 = kr_lo - rw + 7; cq = c0 + r32;
        Kb = A.KA + (size_t)(M_CTX + ub * LAT_N + kr_lo * 64) * 512 + uh * 64; Vb = A.VA + (size_t)(M_CTX + ub * LAT_N + kr_lo * 64) * 512 + uh * 64;
        Kc = A.CKNA + (size_t)(ub * PAST) * 512 + uh * 64; Vc = A.CVNA + (size_t)(ub * PAST) * 512 + uh * 64; }
    else {
        head = 4 * uh + (wid >> 1); const int tb0 = max(0, ux - 2), tb1 = min(31, ux + 2);
        qpos0 = 64 * ux + 32 * (wid & 1); kt00 = 64 * tb0;
        qrow0 = M_CTX + ub * LAT_N + qpos0; qcol = 512 + head * 64; ldk = 128; NB = tb1 - tb0 + 1; NT = NB + 4;
        Kb = A.KB + (size_t)(M_CTX + ub * LAT_N + kt00) * 128 + uh * 64; Vb = A.VB + (size_t)(M_CTX + ub * LAT_N + kt00) * 128 + uh * 64;
        Kc = A.CKSWA + (size_t)(ub * PAST) * 128 + uh * 64; Vc = A.CVSWA + (size_t)(ub * PAST) * 128 + uh * 64; }
    LAS float* TB = (LAS float*)(lds + A_TB);
    if (NA_LAT) {
        const float* rb = A.relb + uh * (15 * 31);
        for (int idx = threadIdx.x; idx < TB_FLOATS; idx += NWAVES * 64) { const int s = idx / (15 * TB_ROW), rem = idx - s * (15 * TB_ROW), dr = rem / TB_ROW, i = rem - dr * TB_ROW, dc = i - 48 - s;
            TB[idx] = (dc >= 0 && dc <= 30) ? rb[dr * 31 + dc] * LOG2E : 0.f; }
    }
    bf16_t* Qw = A.QAB + (size_t)qrow0 * 1024 + qcol;
    bf16x8 qr[4];
#pragma unroll
    for (int d0 = 0; d0 < 4; ++d0) qr[d0] = *(const bf16x8*)(Qw + (size_t)r32 * 1024 + d0 * 16 + hi * 8);
    float mhat = 0.f, lsum = 0.f;
    if (SWA) { mhat = A.sink[head] * LOG2E; lsum = (hi == 0) ? 1.f : 0.f; }
    f32x16 o0, o1;
#pragma unroll
    for (int r = 0; r < 16; ++r) { o0[r] = 0.f; o1[r] = 0.f; }
    unsigned vmask = 0u;
    int lane_tb = 0;
    if (NA_LAT) {
        const int cs = min(max(cq - 8, 0), 48), s = (cq + 1) & 3;
#pragma unroll
        for (int r = 0; r < 16; ++r) { const int kc = crow(r, hi); vmask |= (kc >= cs && kc < cs + 16) ? (1u << r) : 0u; vmask |= (kc + 32 >= cs && kc + 32 < cs + 16) ? (1u << (16 + r)) : 0u; }
        lane_tb = s * 15 * TB_ROW + (63 - cq + s) + 4 * hi;
    }
    LAS float* wsf = (LAS float*)(lds + A_WSF) + wid * 64;
    const size_t koff = (size_t)lane * ldk + wid * 8, voff = (size_t)(16 * (wid & 3) + (lane >> 2)) * ldk + (wid >> 2) * 32 + (lane & 3) * 8;
    const int st_off = wid * 1024 + lane * 16;
    { const u32x4 kreg = *(const u32x4*)(Kb + koff), vreg = *(const u32x4*)(Vb + voff);
      *(LAS u32x4*)(lds + A_K + st_off) = kreg; *(LAS u32x4*)(lds + A_V + st_off) = vreg; }
    __syncthreads();
    for (int t = 0; t < NT; ++t) {
        const int buf = t & 1;
        u32x4 kreg = (u32x4){0u, 0u, 0u, 0u}, vreg = (u32x4){0u, 0u, 0u, 0u};
        if (t + 1 < NT) { const bf16_t* kt = (t + 1 < NB) ? Kb + (size_t)(t + 1) * 64 * ldk : Kc + (size_t)(t + 1 - NB) * 64 * ldk;
                          const bf16_t* vt = (t + 1 < NB) ? Vb + (size_t)(t + 1) * 64 * ldk : Vc + (size_t)(t + 1 - NB) * 64 * ldk;
                          kreg = *(const u32x4*)(kt + koff); vreg = *(const u32x4*)(vt + voff); }
        const bool band = LAT && t < NB;
        if (!(NA_LAT && band && (t < wlo || t > whi))) {
            const LAS unsigned char* kp = lds + A_K + buf * 8192 + hi * 1024 + r32 * 16;
            bf16x8 kf[8];
#pragma unroll
            for (int d0 = 0; d0 < 4; ++d0) { kf[2 * d0] = *(const LAS bf16x8*)(kp + d0 * 2048); kf[2 * d0 + 1] = *(const LAS bf16x8*)(kp + d0 * 2048 + 512); }
            f32x16 p0, p1;
            if (NA_LAT && band) {
                const LAS float* tb = TB + (dr0 + t) * TB_ROW + lane_tb;
#pragma unroll
                for (int g = 0; g < 4; ++g) { const f32x4 b0 = *(const LAS f32x4*)(tb + 8 * g), b1 = *(const LAS f32x4*)(tb + 8 * g + 32);
#pragma unroll
                    for (int e = 0; e < 4; ++e) { p0[4 * g + e] = ((vmask >> (4 * g + e)) & 1u) ? b0[e] - mhat : -1e30f; p1[4 * g + e] = ((vmask >> (16 + 4 * g + e)) & 1u) ? b1[e] - mhat : -1e30f; } }
            } else {
#pragma unroll
                for (int r = 0; r < 16; ++r) { p0[r] = -mhat; p1[r] = -mhat; }
            }
#pragma unroll
            for (int d0 = 0; d0 < 4; ++d0) { p0 = __builtin_amdgcn_mfma_f32_32x32x16_bf16(kf[2 * d0], qr[d0], p0, 0, 0, 0); p1 = __builtin_amdgcn_mfma_f32_32x32x16_bf16(kf[2 * d0 + 1], qr[d0], p1, 0, 0, 0); }
            if (SWA_LAT && band) {
                const int dl0 = kt00 + 64 * t - qpos0;
                if (dl0 - 31 < -128 || dl0 + 63 > 128) {
                    const int dlt = dl0 - r32 + 4 * hi;
#pragma unroll
                    for (int r = 0; r < 16; ++r) { const int d_ = dlt + crow(r, 0); if (d_ < -128 || d_ > 128) p0[r] = -1e30f; if (d_ + 32 < -128 || d_ + 32 > 128) p1[r] = -1e30f; }
                }
            }
            float rm = fmaxf(p0[0], p1[0]);
#pragma unroll
            for (int r = 1; r < 16; ++r) rm = fmaxf(rm, fmaxf(p0[r], p1[r]));
            rm = halves_max(rm);
            if (__any(rm > 0.f)) {
                const float dl = fmaxf(rm, 0.f); mhat += dl;
                const float f = __builtin_amdgcn_exp2f(-dl); lsum *= f;
#pragma unroll
                for (int r = 0; r < 16; ++r) { p0[r] -= dl; p1[r] -= dl; }
                if (hi == 0) wsf[r32] = f;
#pragma unroll
                for (int g = 0; g < 4; ++g) { const f32x4 fv = *(const LAS f32x4*)(wsf + 8 * g + 4 * hi);
#pragma unroll
                    for (int e = 0; e < 4; ++e) { o0[4 * g + e] *= fv[e]; o1[4 * g + e] *= fv[e]; } }
            }
            float sacc = 0.f;
#pragma unroll
            for (int r = 0; r < 16; ++r) { p0[r] = __builtin_amdgcn_exp2f(p0[r]); p1[r] = __builtin_amdgcn_exp2f(p1[r]); sacc += p0[r] + p1[r]; }
            lsum += sacc;
            u32x4 pw[4];
#pragma unroll
            for (int i = 0; i < 4; ++i) { pw[0][i] = cvtpk_s(p0[2 * i], p0[2 * i + 1]); pw[1][i] = cvtpk_s(p0[8 + 2 * i], p0[8 + 2 * i + 1]); pw[2][i] = cvtpk_s(p1[2 * i], p1[2 * i + 1]); pw[3][i] = cvtpk_s(p1[8 + 2 * i], p1[8 + 2 * i + 1]); }
            const LAS unsigned char* vp = lds + A_V + buf * 8192 + ((lane >> 4) & 1) * 32 + (lane & 3) * 8 + (4 * hi + ((lane & 15) >> 2)) * 64;
#pragma unroll
            for (int ks = 0; ks < 4; ++ks) {
                const s16x4 a0 = vtr(vp + ks * 1024), a1 = vtr(vp + ks * 1024 + 512), b0 = vtr(vp + 4096 + ks * 1024), b1 = vtr(vp + 4096 + ks * 1024 + 512);
                const bf16x8 v0 = (bf16x8){a0[0], a0[1], a0[2], a0[3], a1[0], a1[1], a1[2], a1[3]}, v1 = (bf16x8){b0[0], b0[1], b0[2], b0[3], b1[0], b1[1], b1[2], b1[3]};
                const bf16x8 pa = __builtin_bit_cast(bf16x8, pw[ks]);
                o0 = __builtin_amdgcn_mfma_f32_32x32x16_bf16(pa, v0, o0, 0, 0, 0);
                o1 = __builtin_amdgcn_mfma_f32_32x32x16_bf16(pa, v1, o1, 0, 0, 0);
            }
        }
        if (t + 1 < NT) { *(LAS u32x4*)(lds + A_K + (buf ^ 1) * 8192 + st_off) = kreg; *(LAS u32x4*)(lds + A_V + (buf ^ 1) * 8192 + st_off) = vreg; }
        __syncthreads();
    }
    const float ltot = halves_sum(lsum);
    if (hi == 0) wsf[32 + r32] = 1.0f / ltot;
    bf16_t* stg = (bf16_t*)nullptr; LAS bf16_t* sg = (LAS bf16_t*)(lds + A_OST + wid * 4096); (void)stg;
#pragma unroll
    for (int g = 0; g < 4; ++g) { const f32x4 rl = *(const LAS f32x4*)(wsf + 32 + 8 * g + 4 * hi);
#pragma unroll
        for (int e = 0; e < 4; ++e) { const int orow = 8 * g + 4 * hi + e;
            sg[orow * 64 + r32] = (bf16_t)f2bf(o0[4 * g + e] * rl[e]); sg[orow * 64 + 32 + r32] = (bf16_t)f2bf(o1[4 * g + e] * rl[e]); } }
#pragma unroll
    for (int i = 0; i < 4; ++i) { const int row = i * 8 + (lane >> 3), ch = lane & 7; const u32x4 v = *(const LAS u32x4*)(sg + row * 64 + ch * 8); *(u32x4*)(A.OB + (size_t)(qrow0 + row) * 1024 + qcol + ch * 8) = v; }
}

__device__ __forceinline__ void attn_phase(const Ctx& F, const AttnBufs& A) {
    for (int u = F.vcu; u < 1280; u += F.G) {
        if (u < 512) attn_unit<2>(F.lds, A, u >> 6, (u >> 3) & 7, u & 7, F.lane, F.wave);
        else if (u < 1024) { const int v = u - 512; attn_unit<3>(F.lds, A, v >> 6, (v >> 5) & 1, v & 31, F.lane, F.wave); }
        else if (u < 1152) { const int v = u - 1024; attn_unit<0>(F.lds, A, v >> 3, v & 7, 0, F.lane, F.wave); }
        else { const int v = u - 1152; attn_unit<1>(F.lds, A, v >> 3, v & 7, 0, F.lane, F.wave); }
    }
}
}

#define XB_TMO      128
#define XB_XCNT(j)  (256  + 64 * (j))
#define XB_XSUB(j)  (1280 + 64 * (j))
#define XB_XGEN(j)  (2304 + 64 * (j))
#define XB_TOP      3328
#define XB_TOPGEN   3392
#define XCD_BAR_WORDS 3456
#define XB_SPIN_CAP (1u << 18)

__device__ __forceinline__ unsigned xb_ld(unsigned* p)              { return __hip_atomic_load(p, __ATOMIC_RELAXED, __HIP_MEMORY_SCOPE_AGENT); }
__device__ __forceinline__ unsigned xb_add(unsigned* p, unsigned v) { return __hip_atomic_fetch_add(p, v, __ATOMIC_RELAXED, __HIP_MEMORY_SCOPE_AGENT); }
__device__ __forceinline__ unsigned xb_xcc_id() { return (unsigned)__builtin_amdgcn_s_getreg((3 << 11) | 20) & 0xFu; }
#define XB_SPIN(cond, bar) do { unsigned _sp = 0; while (cond) { __builtin_amdgcn_s_sleep(1); \
    if ((++_sp & 255u) == 0u) { if (xb_ld(&(bar)[XB_TMO])) break; if (_sp > XB_SPIN_CAP) { atomicAdd(&(bar)[XB_TMO], 1u); break; } } } } while (0)

struct XcdBarrier {
    unsigned* bar; unsigned x;
    volatile LAS unsigned* st;
};

__device__ __forceinline__ XcdBarrier xcd_barrier_post(unsigned* bar, volatile LAS unsigned* st) {
    XcdBarrier b; b.bar = bar; b.x = xb_xcc_id(); b.st = st;
    if (threadIdx.x == 0) (void)xb_add(&bar[XB_XCNT(b.x)], 1u);
    return b;
}
__device__ __forceinline__ void xcd_barrier_complete(unsigned* bar, unsigned x, unsigned& nloc, unsigned& nx) {
    const unsigned G = gridDim.x * gridDim.y * gridDim.z;
    unsigned sum, cnt, mine, sp = 0u;
    for (;;) {
        sum = 0u; cnt = 0u; mine = 0u;
#pragma unroll
        for (unsigned j = 0; j < 16; ++j) { const unsigned c = xb_ld(&bar[XB_XCNT(j)]); sum += c; cnt += (c > 0u) ? 1u : 0u; mine = (j == x) ? c : mine; }
        if (sum == G) break;
        __builtin_amdgcn_s_sleep(1);
        if ((++sp & 255u) == 0u) { if (xb_ld(&bar[XB_TMO])) break; if (sp > XB_SPIN_CAP) { atomicAdd(&bar[XB_TMO], 1u); break; } }
    }
    nloc = mine > 0u ? mine : 1u; nx = cnt > 0u ? cnt : 1u;
}

__device__ __forceinline__ void xcd_barrier(const XcdBarrier& b) {
    asm volatile("s_waitcnt vmcnt(0)" ::: "memory");
    __syncthreads();
    if (threadIdx.x == 0) {
        unsigned* bar = b.bar;
        __builtin_amdgcn_s_waitcnt(0);
        unsigned nloc = b.st[0], nx = b.st[1];
        if (nloc == 0u) { xcd_barrier_complete(bar, b.x, nloc, nx); b.st[0] = nloc; b.st[1] = nx; }
        const unsigned old = xb_add(&bar[XB_XSUB(b.x)], 1u);
        const unsigned gen = old / nloc;
        if (old + 1u == (gen + 1u) * nloc) {
            __builtin_amdgcn_fence(__ATOMIC_RELEASE, "agent");
            asm volatile("s_waitcnt vmcnt(0)" ::: "memory");
            const unsigned og = xb_add(&bar[XB_TOP], 1u);
            const unsigned tg = og / nx;
            if (og + 1u == (tg + 1u) * nx) xb_add(&bar[XB_TOPGEN], 1u);
            else XB_SPIN(xb_ld(&bar[XB_TOPGEN]) == tg, bar);
            __builtin_amdgcn_fence(__ATOMIC_ACQUIRE, "agent");
            xb_add(&bar[XB_XGEN(b.x)], 1u);
            asm volatile("s_waitcnt vmcnt(0)" ::: "memory");
        } else {
            XB_SPIN(xb_ld(&bar[XB_XGEN(b.x)]) == gen, bar);
            __builtin_amdgcn_fence(__ATOMIC_ACQUIRE, "agent");
            asm volatile("s_waitcnt vmcnt(0)" ::: "memory");
        }
    }
    __syncthreads();
}

struct Args { const float* in[26]; float* out; unsigned char* ws; int ph_lo, ph_hi; };
constexpr int N_PHASES = 12;

__global__ void __launch_bounds__(NWAVES * 64, 2) fwd_kernel(Args args) {
    extern __shared__ __attribute__((aligned(16))) unsigned char lds_raw[];
    Ctx F;
    F.lds = (LAS unsigned char*)lds_raw;
    F.tid = threadIdx.x; F.lane = F.tid & 63; F.wave = __builtin_amdgcn_readfirstlane(F.tid >> 6);
    F.G = gridDim.x; { const int bx = blockIdx.x; F.vcu = (F.G % 8 == 0) ? (bx % 8) * (F.G / 8) + bx / 8 : bx; }
#define ws (args.ws)
#define x_prompt (args.in[0])
#define x_sample (args.in[1])
#define Y (args.out + OUT_Y)
#define MOD ((float*)(ws + WS_MOD))
#define ROPE ((float2*)(ws + WS_ROPE))
#define GS ((float*)(ws + WS_GS))
#define B2IN ((float*)(ws + WS_B2IN))
#define B2GU ((float*)(ws + WS_B2GU))
#define SS ((float*)(ws + WS_SS))
#define WGU1 ((bf16_t*)(ws + WS_WGU1))
#define WD1 ((bf16_t*)(ws + WS_WD1))
#define WIN ((bf16_t*)(ws + WS_WIN))
#define WB ((bf16_t*)(ws + WS_WB))
#define WOUT ((bf16_t*)(ws + WS_WOUT))
#define WGU2 ((bf16_t*)(ws + WS_WGU2))
#define WD2 ((bf16_t*)(ws + WS_WD2))
#define H ((bf16_t*)(ws + WS_H))
#define H2 ((bf16_t*)(ws + WS_H2))
#define ACT ((bf16_t*)(ws + WS_ACT))
#define QAB ((bf16_t*)(ws + WS_QAB))
#define KA ((bf16_t*)(ws + WS_KA))
#define VA ((bf16_t*)(ws + WS_VA))
#define KB ((bf16_t*)(ws + WS_KB))
#define VB ((bf16_t*)(ws + WS_VB))
#define SGNA ((bf16_t*)(ws + WS_SGNA))
#define SGSWA ((bf16_t*)(ws + WS_SGSWA))
#define TMP ((bf16_t*)(ws + WS_TMP))
#define CKNA ((bf16_t*)(ws + WS_CKNA))
#define CVNA ((bf16_t*)(ws + WS_CVNA))
#define CKSWA ((bf16_t*)(ws + WS_CKSWA))
#define CVSWA ((bf16_t*)(ws + WS_CVSWA))
    const int gw = F.vcu * NWAVES + F.wave, NGW = F.G * NWAVES;
    const int lo = args.ph_lo, hi = args.ph_hi;
    unsigned long long ts_a = 0ull, ts_b = 0ull;
#define TS(i) do { if (TIMING_PHASE >= 0 && blockIdx.x == 0 && F.tid == 0) { if ((i) == TIMING_PHASE) ts_a = __builtin_amdgcn_s_memrealtime(); if ((i) == TIMING_PHASE + 1) ts_b = __builtin_amdgcn_s_memrealtime(); } } while (0)
#define IN(k) (lo <= (k) && (k) < hi)
#define REPS(k) for (int rep_ = 0; rep_ < ((PROBE_REP == (k)) ? 2 : 1); ++rep_, (PROBE_REP == (k) && rep_ == 1) ? xcd_barrier(bar) : (void)0)
#if MK_N_LAUNCHES == 1
    for (int u = F.tid; u < (LDS_BYTES - LDSCTL_OFF) / 4; u += NWAVES * 64) ((LAS unsigned*)(F.lds + LDSCTL_OFF))[u] = 0u;
    __syncthreads();
    XcdBarrier bar = xcd_barrier_post((unsigned*)(ws + WS_CTL) + CW_BAR, (volatile LAS unsigned*)(F.lds + MISC_OFF) + 8);
#define SEAM(k) do { if (IN(k) && IN((k) + 1)) { if ((k) == 0) cg::this_grid().sync(); else xcd_barrier(bar); } } while (0)
#else
    XcdBarrier bar; bar.bar = nullptr; bar.x = 0; bar.st = nullptr;
#define SEAM(k) do { } while (0)
#endif

    TS(0);
    if (IN(0)) REPS(0) {
        if (blockIdx.x < 72) {
            LAS float* S = (LAS float*)F.lds; LAS float* RED = (LAS float*)(F.lds + 49152);
            const float* c_lat = args.in[6]; const float* c_ctx = args.in[7]; const float* w_ada = args.in[8]; const float* b_ada = args.in[9];
            for (int idx = F.tid; idx < NCOND * D; idx += NWAVES * 64) { const int i = idx >> 10, k = idx & 1023; const float c = (i == 0) ? c_ctx[k] : c_lat[(i - 1) * D + k]; S[k * 12 + i] = c / (1.0f + __expf(-c)); }
            __syncthreads();
            for (int it = blockIdx.x; it < 72; it += F.G) {
                const int n0 = it * 128, k0 = F.wave * 128;
                float a[NCOND][2];
#pragma unroll
                for (int i = 0; i < NCOND; ++i) { a[i][0] = 0.f; a[i][1] = 0.f; }
#pragma unroll 8
                for (int kk = 0; kk < 128; ++kk) { const int k = k0 + kk; const float2 w = *(const float2*)(w_ada + (size_t)k * MODW + n0 + 2 * F.lane);
#pragma unroll
                    for (int i = 0; i < NCOND; ++i) { const float s = S[k * 12 + i]; a[i][0] += s * w.x; a[i][1] += s * w.y; } }
#pragma unroll
                for (int i = 0; i < NCOND; ++i) { RED[(F.wave * NCOND + i) * 128 + 2 * F.lane] = a[i][0]; RED[(F.wave * NCOND + i) * 128 + 2 * F.lane + 1] = a[i][1]; }
                __syncthreads();
                for (int idx = F.tid; idx < NCOND * 128; idx += NWAVES * 64) { const int i = idx >> 7, c = idx & 127; float s = b_ada[n0 + c];
#pragma unroll
                    for (int w = 0; w < NWAVES; ++w) s += RED[(w * NCOND + i) * 128 + c];
                    MOD[(size_t)i * MODW + n0 + c] = s; }
                __syncthreads();
            }
        }
        if (blockIdx.x == F.G - 1) {
            for (int idx = F.tid; idx < 64 * 16; idx += NWAVES * 64) { const int pos = idx >> 4, i = idx & 15; const float fr_ = powf(10000.0f, -(float)i / 16.0f); const float ang = (float)pos * fr_; ROPE[idx] = make_float2(cosf(ang), sinf(ang)); }
        }
        {
            LAS unsigned char* scr = F.lds + F.wave * 16384;
            const int gwr = ((int)blockIdx.x >= 72 ? (int)blockIdx.x - 72 : (int)blockIdx.x + (F.G - 72)) * NWAVES + F.wave;
            for (int it = gwr; it < I_ALL; it += NGW) {
                int r = it;
                if (r < I_GU) { tr_gu(args.in[11], WGU1, 0, scr, r, F.lane); continue; } r -= I_GU;
                if (r < I_GU) { tr_gu(args.in[12], WGU1, 1, scr, r, F.lane); continue; } r -= I_GU;
                if (r < I_DN) { tr_plain(args.in[13], FF, D, WD1, FF, 0, scr, r, F.lane); continue; } r -= I_DN;
                if (r < I_IN) { tr_plain(args.in[15], D, NIN, WIN, D, 0, scr, r, F.lane); continue; } r -= I_IN;
                if (r < I_BR) { tr_plain(args.in[18], 512, D, WB, D, 0, scr, r, F.lane); continue; } r -= I_BR;
                if (r < I_BR) { tr_plain(args.in[19], 512, D, WB, D, 512, scr, r, F.lane); continue; } r -= I_BR;
                if (r < I_OUT) { tr_plain(args.in[20], D, D, WOUT, D, 0, scr, r, F.lane); continue; } r -= I_OUT;
                if (r < I_GU) { tr_gu(args.in[22], WGU2, 0, scr, r, F.lane); continue; } r -= I_GU;
                if (r < I_GU) { tr_gu(args.in[23], WGU2, 1, scr, r, F.lane); continue; } r -= I_GU;
                tr_plain(args.in[24], FF, D, WD2, FF, 0, scr, r, F.lane);
            }
        }
        {
            const int gt = (F.vcu * NWAVES * 64) + F.tid, NT = F.G * NWAVES * 64;
            constexpr int N4A = 8 * 256 * 512 / 4, N4B = 8 * 256 * 128 / 4;
            for (int i = gt; i < 2 * N4A + 2 * N4B; i += NT) {
                int r = i; const float* src; bf16_t* dst;
                if (r < N4A) { src = args.in[2]; dst = CKNA; } else if ((r -= N4A) < N4A) { src = args.in[3]; dst = CVNA; } else if ((r -= N4A) < N4B) { src = args.in[4]; dst = CKSWA; } else { r -= N4B; src = args.in[5]; dst = CVSWA; }
                const f32x4 v = ((const f32x4*)src)[r]; u32x2 w; w.x = pk2(v.x, v.y); w.y = pk2(v.z, v.w); ((u32x2*)dst)[r] = w;
            }
        }
    }
    SEAM(0); TS(1);
    if (IN(1)) REPS(1) {
        norm_rows<false>(x_prompt, x_sample, H, args.in[10], MOD, 1, 0, gw, NGW, F.lane);
        { const int gt = (F.vcu * NWAVES * 64) + F.tid, NT = F.G * NWAVES * 64;
          for (int i = gt; i < 2 * NCOND * D; i += NT) { const int st = i / (NCOND * D), r = i - st * NCOND * D, c = r >> 10, k = r & 1023;
              GS[i] = (st == 0 ? args.in[14][k] : args.in[21][k]) * (1.0f + MOD[(size_t)c * MODW + (st == 0 ? 4 : 7) * D + k]); } }
        for (int it = gw; it < (NIN + 2 * FF) / 16; it += NGW) {
            const bool in_ = it < NIN / 16; const int n0 = 16 * (in_ ? it : it - NIN / 16), nl = F.lane & 15, kq = F.lane >> 4;
            const bf16_t* wp = (in_ ? WIN : WGU2) + (size_t)(n0 + nl) * D + 8 * kq;
            const float* shp = MOD + (size_t)min(nl, NCOND - 1) * MODW + (in_ ? 3 : 6) * D + 8 * kq;
            f32x4 acc4 = (f32x4){0.f, 0.f, 0.f, 0.f};
#pragma unroll 8
            for (int s = 0; s < 32; ++s) {
                const pg8::bf16x8 bfr = *(const pg8::bf16x8*)(wp + 32 * s);
                f32x4 a0 = *(const f32x4*)(shp + 32 * s), a1 = *(const f32x4*)(shp + 32 * s + 4);
                if (nl >= NCOND) { a0 = (f32x4){0.f, 0.f, 0.f, 0.f}; a1 = a0; }
                u32x4 aw; aw.x = cvt_pk_bf16(a0.x, a0.y); aw.y = cvt_pk_bf16(a0.z, a0.w); aw.z = cvt_pk_bf16(a1.x, a1.y); aw.w = cvt_pk_bf16(a1.z, a1.w);
                acc4 = __builtin_amdgcn_mfma_f32_16x16x32_bf16(__builtin_bit_cast(pg8::bf16x8, aw), bfr, acc4, 0, 0, 0);
            }
            float* dst = in_ ? B2IN : B2GU; const int ldn = in_ ? NIN : 2 * FF;
#pragma unroll
            for (int r = 0; r < 4; ++r) { const int c = 4 * kq + r; if (c < NCOND) dst[(size_t)c * ldn + n0 + nl] = acc4[r]; }
        }
    }
    SEAM(1); TS(2);
    if (IN(2)) REPS(2) {
        pg8::Gemm g{H, WGU1, D, D, M, 2 * FF, D}; pg8::StaticOrder S; S.init(M, 2 * FF, F.G, (int)blockIdx.x);
        EpiSwiGLU<false> E{ws};
        pg8::gemm_phase<EpiSwiGLU<false>, pg8::StaticOrder, true, true>(F.lds, g, S, E);
    }
    SEAM(2); TS(3);
    if (IN(3)) REPS(3) {
        pg8::Gemm g{ACT, WD1, FF, FF, M, D, FF}; pg8::StaticOrder S; S.init(M, D, F.G, (int)blockIdx.x);
        EpiResid<0> E{x_prompt, x_sample, Y, ws};
        pg8::gemm_phase<EpiResid<0>, pg8::StaticOrder, true, true>(F.lds, g, S, E);
    }
    SEAM(3); TS(4);
    if (IN(4)) {
        pg8::Gemm g{H2, WIN, D, D, M, NIN, D}; pg8::StaticOrder S; S.init(M, NIN, F.G, (int)blockIdx.x);
        EpiIn E{ws, args.out};
        pg8::gemm_phase<EpiIn, pg8::StaticOrder, true, true>(F.lds, g, S, E);
    }
    SEAM(4); TS(5);
    if (IN(5)) {
        AttnBufs A{QAB, QAB, KA, VA, KB, VB, CKNA, CVNA, CKSWA, CVSWA, args.in[16], args.in[17]};
#if ATTN_DEBUG
        { const int gt = (F.vcu * NWAVES * 64) + F.tid, NT_ = F.G * NWAVES * 64;
          for (size_t i = gt; i < (size_t)M * 1024 / 8; i += NT_) ((u32x4*)H)[i] = ((const u32x4*)QAB)[i]; }
        cg::this_grid().sync();
        att::attn_phase(F, A);
        { AttnBufs A2{H, H, KA, VA, KB, VB, CKNA, CVNA, CKSWA, CVSWA, args.in[16], args.in[17]}; attn_naive_phase(F, A2); }
        cg::this_grid().sync();
        { float sd[4] = {0.f, 0.f, 0.f, 0.f}, sr[4] = {0.f, 0.f, 0.f, 0.f};
          const int gt = (F.vcu * NWAVES * 64) + F.tid, NT_ = F.G * NWAVES * 64;
          for (size_t i = gt; i < (size_t)M * 1024 / 8; i += NT_) {
              const int row = (int)(i >> 7), col = (int)(i & 127) * 8; const int ty = (row >= M_CTX ? 2 : 0) + (col >= 512 ? 1 : 0);
              const u32x4 a = ((const u32x4*)QAB)[i], b = ((const u32x4*)H)[i]; float d2 = 0.f, r2 = 0.f;
#pragma unroll
              for (int e = 0; e < 4; ++e) { const float a0 = __uint_as_float(a[e] << 16), a1 = __uint_as_float(a[e] & 0xffff0000u), b0 = __uint_as_float(b[e] << 16), b1 = __uint_as_float(b[e] & 0xffff0000u);
                  d2 += (a0 - b0) * (a0 - b0) + (a1 - b1) * (a1 - b1); r2 += b0 * b0 + b1 * b1; }
#pragma unroll
              for (int k = 0; k < 4; ++k) { sd[k] += (ty == k) ? d2 : 0.f; sr[k] += (ty == k) ? r2 : 0.f; } }
#pragma unroll
          for (int k = 0; k < 4; ++k) { const float d = wave_sum(sd[k]), r = wave_sum(sr[k]); if (F.lane == 0) { atomicAdd((float*)(ws + WS_CTL) + 64 * (2 * k), d); atomicAdd((float*)(ws + WS_CTL) + 64 * (2 * k + 1), r); } } }
#else
        if (PROBE_REP == 5) { AttnBufs A2{H2, QAB, KA, VA, KB, VB, CKNA, CVNA, CKSWA, CVSWA, args.in[16], args.in[17]}; att::attn_phase(F, A2); xcd_barrier(bar); }
        att::attn_phase(F, A);
#endif
    }
    SEAM(5); TS(6);
    if (IN(6)) REPS(6) {
        pg8::Gemm g{QAB, WB, D, D, M, D, 512}; pg8::StaticOrder S; S.init(M, D, F.G, (int)blockIdx.x);
        EpiMerge<false> E{ws};
        pg8::gemm_phase<EpiMerge<false>, pg8::StaticOrder, true, true>(F.lds, g, S, E);
    }
    SEAM(6); TS(7);
    if (IN(7)) REPS(7) {
        pg8::Gemm g{QAB + 512, WB + 512, D, D, M, D, 512}; pg8::StaticOrder S; S.init(M, D, F.G, (int)blockIdx.x);
        EpiMerge<true> E{ws};
        pg8::gemm_phase<EpiMerge<true>, pg8::StaticOrder, true, true>(F.lds, g, S, E);
    }
    SEAM(7); TS(8);
    if (IN(8)) {
        pg8::Gemm g{H, WOUT, D, D, M, D, D}; pg8::StaticOrder S; S.init(M, D, F.G, (int)blockIdx.x);
        EpiResid<1> E{nullptr, nullptr, Y, ws};
        pg8::gemm_phase<EpiResid<1>, pg8::StaticOrder, true, true>(F.lds, g, S, E);
    }
    SEAM(8); TS(9);
    if (IN(9)) REPS(9) {
        pg8::Gemm g{H2, WGU2, D, D, M, 2 * FF, D}; pg8::StaticOrder S; S.init(M, 2 * FF, F.G, (int)blockIdx.x);
        EpiSwiGLU<true> E{ws};
        pg8::gemm_phase<EpiSwiGLU<true>, pg8::StaticOrder, true, true>(F.lds, g, S, E);
    }
    SEAM(9); TS(10);
    if (IN(10)) {
        pg8::Gemm g{ACT, WD2, FF, FF, M, D, FF}; pg8::StaticOrder S; S.init(M, D, F.G, (int)blockIdx.x);
        EpiResid<2> E{nullptr, nullptr, Y, ws};
        pg8::gemm_phase<EpiResid<2>, pg8::StaticOrder, true, true>(F.lds, g, S, E);
    }
    SEAM(10); TS(11);
    if (IN(11)) {
        norm_rows<true>(Y, Y + (size_t)M_CTX * D, Y, args.in[25], nullptr, 0, 0, gw, NGW, F.lane);
#if ATTN_DEBUG
        { const float* cw = (const float*)(ws + WS_CTL); bool bad[4];
#pragma unroll
          for (int k = 0; k < 4; ++k) bad[k] = !(cw[64 * (2 * k)] <= ATTN_DEBUG_TOL * cw[64 * (2 * k + 1)]);
          asm volatile("s_waitcnt vmcnt(0)" ::: "memory"); __syncthreads();
          if (blockIdx.x == 0 && F.tid == 0) { const float qn = __builtin_nanf("");
              if (bad[0]) args.out[OUT_NAK] = qn;
              if (bad[1]) args.out[OUT_NAV] = qn;
              if (bad[2]) args.out[OUT_SWK] = qn;
              if (bad[3]) args.out[OUT_SWV] = qn; } }
#endif
    }
    if (TIMING_PHASE >= 0) { xcd_barrier(bar); TS(12);
        if (blockIdx.x == 0 && F.tid == 0) { const unsigned long long t_end = __builtin_amdgcn_s_memrealtime() + (unsigned long long)TIMING_ALPHA * (ts_b - ts_a);
            while (__builtin_amdgcn_s_memrealtime() < t_end) __builtin_amdgcn_s_sleep(16); } }
#undef TS
#undef IN
#undef SEAM
#undef REPS
#undef ws
#undef x_prompt
#undef x_sample
#undef Y
#undef MOD
#undef ROPE
#undef GS
#undef B2IN
#undef B2GU
#undef SS
#undef WGU1
#undef WD1
#undef WIN
#undef WB
#undef WOUT
#undef WGU2
#undef WD2
#undef H
#undef H2
#undef ACT
#undef QAB
#undef KA
#undef VA
#undef KB
#undef VB
#undef SGNA
#undef SGSWA
#undef TMP
#undef CKNA
#undef CVNA
#undef CKSWA
#undef CVSWA
}

extern "C" void kernel_launch(void* const* d_in, const int* in_sizes, int n_in, void* d_out, int out_size, void* d_ws, size_t ws_size, hipStream_t stream) {
    static int grid = 0;
    if (grid == 0) {
        if (n_in != 26 || out_size != (int)OUT_END || ws_size < WS_END) { fprintf(stderr, "kernel_launch: unexpected shapes (n_in %d out %d ws %zu); nothing launched\n", n_in, out_size, ws_size); grid = -1; return; }
        int dev = 0, cus = 0, per_cu = 0;
        if (hipGetDevice(&dev) != hipSuccess || hipDeviceGetAttribute(&cus, hipDeviceAttributeMultiprocessorCount, dev) != hipSuccess) { grid = -1; return; }
        if (hipFuncSetAttribute((const void*)fwd_kernel, hipFuncAttributeMaxDynamicSharedMemorySize, LDS_BYTES) != hipSuccess) { fprintf(stderr, "kernel_launch: hipFuncSetAttribute failed\n"); grid = -1; return; }
        if (hipOccupancyMaxActiveBlocksPerMultiprocessor(&per_cu, (const void*)fwd_kernel, NWAVES * 64, LDS_BYTES) != hipSuccess || per_cu < 1) { fprintf(stderr, "kernel_launch: occupancy query says %d\n", per_cu); per_cu = 1; }
        (void)hipGetLastError();
        grid = cus;
    }
    if (grid < 0) return;
    if (hipMemsetAsync((char*)d_ws + WS_CTL, 0, CTL_ZERO_BYTES, stream) != hipSuccess) { fprintf(stderr, "kernel_launch: memset failed\n"); return; }
    Args a{};
    for (int i = 0; i < 26; ++i) a.in[i] = (const float*)d_in[i];
    a.out = (float*)d_out; a.ws = (unsigned char*)d_ws;
#if MK_N_LAUNCHES == 1
    a.ph_lo = 0; a.ph_hi = N_PHASES;
    void* kargs[] = {&a};
    hipError_t e = hipLaunchCooperativeKernel((const void*)fwd_kernel, dim3(grid), dim3(NWAVES * 64), kargs, LDS_BYTES, stream);
    if (e != hipSuccess) fprintf(stderr, "cooperative launch failed: %s (grid %d)\n", hipGetErrorString(e), grid);
#else
    for (int p = 0; p < N_PHASES; ++p) { a.ph_lo = p; a.ph_hi = p + 1; hipLaunchKernelGGL(fwd_kernel, dim3(grid), dim3(NWAVES * 64), LDS_BYTES, stream, a); }
#endif
}
```

```cpp
#include <hip/hip_runtime.h>
#include <hip/hip_cooperative_groups.h>
#include <cstdio>
#include <cstdint>
namespace cg = cooperative_groups;

#ifndef ATTN_DEBUG
#define ATTN_DEBUG 0
#endif
#define ATTN_DEBUG_TOL 2e-5f
#ifndef POISON_DEBUG
#define POISON_DEBUG 0
#endif
#ifndef TIMING_PHASE
#define TIMING_PHASE -1
#endif
#define TIMING_ALPHA 8
#ifndef PROBE_REP
#define PROBE_REP -1
#endif
#ifndef MK_N_LAUNCHES
#define MK_N_LAUNCHES 1
#endif

namespace pg8 {
#define PG8_LAS __attribute__((address_space(3)))
typedef unsigned short bf16_t;
typedef short bf16x8 __attribute__((ext_vector_type(8)));
typedef float f32x4 __attribute__((ext_vector_type(4)));
typedef unsigned u32x4 __attribute__((ext_vector_type(4)));
typedef unsigned u32x2 __attribute__((ext_vector_type(2)));
constexpr int BM = 256, BK = 64, HALF = 128, HTB = HALF * BK * 2  , STAGE_BYTES = 8 * HTB, NXCD = 8, WGM = 8;

__host__ __device__ __forceinline__ int lds_byte(int r, int c) { const int st = (r >> 4) * 2 + (c >> 5), rr = r & 15, cc = c & 31, ob = rr * 64 + cc * 2; return st * 1024 + (ob ^ (((ob >> 9) & 1) << 5)); }
__host__ __device__ __forceinline__ void stage_rc(int b, int& R, int& C) { const int st = b / 1024, sb = b % 1024, swz = sb ^ (((sb >> 9) & 1) << 5); R = (st >> 1) * 16 + swz / 64; C = (st & 1) * 32 + (swz % 64) / 2; }
__host__ __device__ __forceinline__ int perm32(int rho) { const int n = rho >> 4, i = rho & 15; return 8 * (i >> 2) + 4 * n + (i & 3); }

struct Unit { int pm, pn; };
struct Gemm { const bf16_t* A; const bf16_t* Bt; int lda, ldb, M, N, K; };

struct StaticOrder {
    int nM, nN, nwg, G, c;
    __host__ __device__ void init(int M, int N, int G_, int c_) { nM = M / BM; nN = N / BM; nwg = nM * nN; G = G_; c = c_; }
    __host__ __device__ bool next(int i, Unit& u) const {
        const long L = (long)i * G + c; if (L >= nwg) return false;
        int wgid = (int)L; { const int q = nwg / NXCD, r = nwg % NXCD, xcd = wgid % NXCD, off = wgid / NXCD; wgid = (xcd < r ? xcd * (q + 1) : r * (q + 1) + (xcd - r) * q) + off; }
        const int nig = WGM * nN, gid = wgid / nig, fm = gid * WGM, gsz = (nM - fm) < WGM ? (nM - fm) : WGM;
        u.pm = fm + ((wgid % nig) % gsz); u.pn = (wgid % nig) / gsz; return true;
    }
    __device__ __forceinline__ void a_ready(const Unit&) const {}
    __device__ __forceinline__ void done(const Unit&) const {}
};
typedef float f32x2_cv __attribute__((ext_vector_type(2))); typedef __bf16 bf16x2_cv __attribute__((ext_vector_type(2)));
__device__ __forceinline__ unsigned cvt_pk_bf16(float lo, float hi) { f32x2_cv v = {lo, hi}; bf16x2_cv b = __builtin_convertvector(v, bf16x2_cv); return __builtin_bit_cast(unsigned, b); }

template <class Epi, class Sched, bool ALIGN_EPI = false, bool SP2 = false>
__device__ __forceinline__ void gemm_phase(PG8_LAS unsigned char* lds, const Gemm g, const Sched& S, const Epi& E) {
    const int tid = threadIdx.x, wid = __builtin_amdgcn_readfirstlane(tid >> 6), lane = tid & 63, wr = wid >> 2, wc = wid & 3, fr = lane & 15, fq = lane >> 4;
    const int K = g.K, nt = K / BK;
    unsigned voffA[2], voffB[2];
#pragma unroll
    for (int i = 0; i < 2; ++i) { int R, C; stage_rc(tid * 16 + i * 8192, R, C); const int Rb = Epi::PERM ? ((R & ~31) + perm32(R & 31)) : R;
        voffA[i] = (unsigned)(R * g.lda + C) * 2u; voffB[i] = (unsigned)(Rb * g.ldb + C) * 2u; }
    const size_t kstep = (size_t)(BK * 2);
    const size_t hstepA = (size_t)HALF * g.lda * 2, hstepB = (size_t)HALF * g.ldb * 2;
    const size_t tstepA = 2 * hstepA, tstepB = 2 * hstepB;
    const unsigned ldsw = (unsigned)wid * 1024u;
    const int aoff = lds_byte(wr * 64 + fr, fq * 8), boff = lds_byte(wc * 32 + fr, fq * 8);
#define PG8_SA(b, h) (((b) * 2 + (h)) * HTB)
#define PG8_SB(b, h) ((4 + (b) * 2 + (h)) * HTB)
#define PG8_STAGE(bufoff, gbase, voff) do { _Pragma("unroll") for (int _i = 0; _i < 2; ++_i) \
        __builtin_amdgcn_global_load_lds((const unsigned*)((const char*)(gbase) + (voff)[_i]), (PG8_LAS unsigned*)(lds + (bufoff) + ldsw + _i * 8192), 16, 0, 0); } while (0)
#define PG8_LDA(dst, b, h) do { _Pragma("unroll") for (int m = 0; m < 4; ++m) _Pragma("unroll") for (int k = 0; k < 2; ++k) dst[m][k] = *(const PG8_LAS bf16x8*)(lds + PG8_SA(b, h) + aoff + m * 2048 + k * 1024); } while (0)
#define PG8_LDB(dst, b, h) do { _Pragma("unroll") for (int n = 0; n < 2; ++n) _Pragma("unroll") for (int k = 0; k < 2; ++k) dst[n][k] = *(const PG8_LAS bf16x8*)(lds + PG8_SB(b, h) + boff + n * 2048 + k * 1024); } while (0)
#define PG8_MMA(ai, bj, At, Bt) do { __builtin_amdgcn_s_setprio(1); _Pragma("unroll") for (int m = 0; m < 4; ++m) _Pragma("unroll") for (int n = 0; n < 2; ++n) _Pragma("unroll") for (int k = 0; k < 2; ++k) \
        acc[ai][bj][m][n] = __builtin_amdgcn_mfma_f32_16x16x32_bf16(Bt[n][k], At[m][k], acc[ai][bj][m][n], 0, 0, 0); __builtin_amdgcn_s_setprio(0); } while (0)
#define PG8_WAIT_V(n) asm volatile("s_waitcnt vmcnt(" #n ")" ::: "memory")
#define PG8_WAIT_L(n) asm volatile("s_waitcnt lgkmcnt(" #n ")" ::: "memory")
#define PG8_BAR __builtin_amdgcn_s_barrier()
#define PG8_SCHED __builtin_amdgcn_sched_barrier(0)
    Unit cur, nxt; int ui = 0;
    if (!S.next(0, cur)) return;
    f32x4 acc[2][2][4][2];
#pragma unroll
    for (int a = 0; a < 2; ++a)
#pragma unroll
        for (int b = 0; b < 2; ++b)
#pragma unroll
            for (int m = 0; m < 4; ++m)
#pragma unroll
                for (int n = 0; n < 2; ++n) acc[a][b][m][n] = (f32x4){0.f, 0.f, 0.f, 0.f};
    bf16x8 At[4][2], B0[2][2], B1[2][2];
    const char* cA = (const char*)g.A + (size_t)cur.pm * tstepA; const char* cB = (const char*)g.Bt + (size_t)cur.pn * tstepB;
    S.a_ready(cur);
    if constexpr (SP2) {
        PG8_STAGE(PG8_SB(0, 0), cB, voffB); PG8_STAGE(PG8_SB(0, 1), cB + hstepB, voffB); PG8_STAGE(PG8_SA(0, 0), cA, voffA); PG8_STAGE(PG8_SA(0, 1), cA + hstepA, voffA);
        if (wr == 1) PG8_BAR;
        PG8_WAIT_V(2); PG8_BAR;
        PG8_STAGE(PG8_SB(1, 0), cB + kstep, voffB); PG8_STAGE(PG8_SA(1, 0), cA + kstep, voffA); PG8_STAGE(PG8_SB(1, 1), cB + hstepB + kstep, voffB);
        PG8_WAIT_V(6); PG8_BAR;
    } else {
        PG8_STAGE(PG8_SB(0, 0), cB, voffB); PG8_STAGE(PG8_SA(0, 0), cA, voffA); PG8_STAGE(PG8_SB(0, 1), cB + hstepB, voffB); PG8_STAGE(PG8_SA(0, 1), cA + hstepA, voffA);
        if (wr == 1) PG8_BAR;
        PG8_WAIT_V(4); PG8_BAR;
        PG8_STAGE(PG8_SB(1, 0), cB + kstep, voffB); PG8_STAGE(PG8_SA(1, 0), cA + kstep, voffA); PG8_STAGE(PG8_SB(1, 1), cB + hstepB + kstep, voffB);
        PG8_WAIT_V(6); PG8_BAR;
    }
    for (;;) {
        const bool has_next = S.next(ui + 1, nxt);
        const char* nA = has_next ? (const char*)g.A + (size_t)nxt.pm * tstepA : cA; const char* nB = has_next ? (const char*)g.Bt + (size_t)nxt.pn * tstepB : cB;
        for (int t = 0; t < nt; t += 2) {
            const bool last = (t == nt - 2);
            const char* a1 = cA + (size_t)(t + 1) * kstep;
            const char* a2 = last ? nA : cA + (size_t)(t + 2) * kstep; const char* b2 = last ? nB : cB + (size_t)(t + 2) * kstep;
            const char* a3 = a2 + kstep; const char* b3 = b2 + kstep;
            if (last && has_next) S.a_ready(nxt);
            if constexpr (SP2) {
            PG8_LDB(B0, 0, 0); PG8_LDB(B1, 0, 1); PG8_SCHED; PG8_LDA(At, 0, 0); PG8_STAGE(PG8_SA(1, 1), a1 + hstepA, voffA);
            PG8_WAIT_V(8); PG8_WAIT_L(0); PG8_BAR; PG8_MMA(0, 0, At, B0); PG8_MMA(0, 1, At, B1); PG8_BAR; PG8_SCHED;
            PG8_LDA(At, 0, 1); PG8_STAGE(PG8_SB(0, 0), b2, voffB); PG8_STAGE(PG8_SB(0, 1), b2 + hstepB, voffB); PG8_STAGE(PG8_SA(0, 0), a2, voffA);
            PG8_WAIT_V(8); PG8_WAIT_L(0); PG8_BAR; PG8_MMA(1, 0, At, B0); PG8_MMA(1, 1, At, B1); PG8_BAR; PG8_SCHED;
            PG8_LDB(B0, 1, 0); PG8_LDB(B1, 1, 1); PG8_SCHED; PG8_LDA(At, 1, 0); PG8_STAGE(PG8_SA(0, 1), a2 + hstepA, voffA);
            PG8_WAIT_V(8); PG8_WAIT_L(0); PG8_BAR; PG8_MMA(0, 0, At, B0); PG8_MMA(0, 1, At, B1); PG8_BAR; PG8_SCHED;
            PG8_LDA(At, 1, 1); PG8_STAGE(PG8_SB(1, 0), b3, voffB); PG8_STAGE(PG8_SB(1, 1), b3 + hstepB, voffB); PG8_STAGE(PG8_SA(1, 0), a3, voffA);
            PG8_WAIT_V(8); PG8_WAIT_L(0); PG8_BAR; PG8_MMA(1, 0, At, B0); PG8_MMA(1, 1, At, B1); PG8_BAR; PG8_SCHED;
            } else {
            PG8_LDB(B0, 0, 0); PG8_SCHED; PG8_LDA(At, 0, 0); PG8_STAGE(PG8_SA(1, 1), a1 + hstepA, voffA);
            PG8_WAIT_L(8); PG8_BAR; PG8_WAIT_L(0); PG8_MMA(0, 0, At, B0); PG8_BAR; PG8_SCHED;
            PG8_LDB(B1, 0, 1); PG8_STAGE(PG8_SB(0, 0), b2, voffB);
            PG8_BAR; PG8_WAIT_L(0); PG8_MMA(0, 1, At, B1); PG8_BAR;
            PG8_LDA(At, 0, 1); PG8_STAGE(PG8_SA(0, 0), a2, voffA);
            PG8_BAR; PG8_WAIT_L(0); PG8_MMA(1, 0, At, B0); PG8_BAR; PG8_SCHED;
            PG8_STAGE(PG8_SB(0, 1), b2 + hstepB, voffB);
            PG8_WAIT_V(6); PG8_BAR; PG8_MMA(1, 1, At, B1); PG8_BAR;
            PG8_LDB(B0, 1, 0); PG8_SCHED; PG8_LDA(At, 1, 0); PG8_STAGE(PG8_SA(0, 1), a2 + hstepA, voffA);
            PG8_WAIT_L(8); PG8_BAR; PG8_WAIT_L(0); PG8_MMA(0, 0, At, B0); PG8_BAR; PG8_SCHED;
            PG8_LDB(B1, 1, 1); PG8_STAGE(PG8_SB(1, 0), b3, voffB);
            PG8_BAR; PG8_WAIT_L(0); PG8_MMA(0, 1, At, B1); PG8_BAR;
            PG8_LDA(At, 1, 1); PG8_STAGE(PG8_SA(1, 0), a3, voffA);
            PG8_BAR; PG8_WAIT_L(0); PG8_MMA(1, 0, At, B0); PG8_BAR; PG8_SCHED;
            PG8_STAGE(PG8_SB(1, 1), b3 + hstepB, voffB);
            PG8_WAIT_V(6); PG8_BAR; PG8_MMA(1, 1, At, B1); PG8_BAR;
            }
        }
        if constexpr (ALIGN_EPI) { if (wr == 0) PG8_BAR; }
        if constexpr (!Epi::AFTER_DRAIN) { E(acc, cur, wr, wc, fr, fq); S.done(cur); }
        if (!has_next) break;
#pragma unroll
        for (int a = 0; a < 2; ++a)
#pragma unroll
            for (int b = 0; b < 2; ++b)
#pragma unroll
                for (int m = 0; m < 4; ++m)
#pragma unroll
                    for (int n = 0; n < 2; ++n) acc[a][b][m][n] = (f32x4){0.f, 0.f, 0.f, 0.f};
        cur = nxt; cA = nA; cB = nB; ++ui;
        if constexpr (ALIGN_EPI) { if (wr == 1) PG8_BAR; }
    }
    PG8_WAIT_V(0);
    if constexpr (!ALIGN_EPI) { if (wr == 0) PG8_BAR; }
    PG8_BAR;
    if constexpr (Epi::AFTER_DRAIN) { E.fused(acc, cur, wr, wc, fr, fq, lds, wid, lane); S.done(cur); }
#undef PG8_SA
#undef PG8_SB
#undef PG8_STAGE
#undef PG8_LDA
#undef PG8_LDB
#undef PG8_MMA
#undef PG8_WAIT_V
#undef PG8_WAIT_L
#undef PG8_BAR
#undef PG8_SCHED
}
}

using pg8::bf16_t; using pg8::f32x4; using pg8::u32x4; using pg8::u32x2; using pg8::Unit; using pg8::cvt_pk_bf16;
#define LAS __attribute__((address_space(3)))

constexpr int D = 1024, FF = 2816, NIN = 4352;
constexpr int M_CTX = 4096, M_LAT = 16384, M = M_CTX + M_LAT;
constexpr int LAT_N = 2048, CTX_L = 256, PAST = 256, GRID_W = 64;
constexpr int NCOND = 9, MODW = 9 * D;
constexpr float EPS = 1e-6f, LOG2E = 1.4426950408889634f, QSCALE = 0.125f * LOG2E;
constexpr int NWAVES = 8;

constexpr size_t OUT_Y = 0, OUT_NAK = (size_t)M * D, OUT_NAV = OUT_NAK + (size_t)M_CTX * 512, OUT_SWK = OUT_NAV + (size_t)M_CTX * 512, OUT_SWV = OUT_SWK + (size_t)M_CTX * 128, OUT_END = OUT_SWV + (size_t)M_CTX * 128;

constexpr size_t MiB = 1u << 20;
constexpr size_t WS_CTL = 0, CTL_ZERO_BYTES = 1 * MiB;
constexpr size_t WS_MOD = 1 * MiB;
constexpr size_t WS_ROPE = 1 * MiB + 512 * 1024;
constexpr size_t WS_GS = 2 * MiB;
constexpr size_t WS_B2IN = 2 * MiB + 256 * 1024;
constexpr size_t WS_B2GU = 2 * MiB + 512 * 1024;
constexpr size_t WS_SS = 3 * MiB;
constexpr size_t WS_WGU1 = 8 * MiB;
constexpr size_t WS_WD1 = 19 * MiB;
constexpr size_t WS_WIN = WS_WD1 + 5 * MiB + 512 * 1024;
constexpr size_t WS_WB = 33 * MiB;
constexpr size_t WS_WOUT = 35 * MiB;
constexpr size_t WS_WGU2 = 37 * MiB, WS_WD2 = 48 * MiB;
constexpr size_t WS_CKNA = 54 * MiB, WS_CVNA = 56 * MiB, WS_CKSWA = 58 * MiB, WS_CVSWA = 58 * MiB + 512 * 1024;
constexpr size_t WS_H = 60 * MiB;
constexpr size_t WS_H2 = 100 * MiB;
constexpr size_t WS_R = 140 * MiB;
constexpr size_t WS_ACT = WS_R;
constexpr size_t WS_QAB = WS_R, WS_KA = WS_R + 40 * MiB, WS_VA = WS_R + 60 * MiB, WS_KB = WS_R + 80 * MiB, WS_VB = WS_R + 85 * MiB;
constexpr size_t WS_SGNA = WS_R + 90 * MiB, WS_SGSWA = WS_R + 130 * MiB;
constexpr size_t WS_TMP = WS_KA;
constexpr size_t WS_END = WS_R + 170 * MiB;
static_assert(WS_WIN + (size_t)NIN * D * 2 <= WS_WB && WS_WD2 + (size_t)D * FF * 2 <= WS_CKNA && WS_SS + (size_t)2 * M * 16 * 4 <= WS_WGU1 && WS_B2GU + 9 * 5632 * 4 <= WS_SS, "ws map");

constexpr int RING_BYTES = 131072, LDSCTL_OFF = RING_BYTES, MISC_OFF = LDSCTL_OFF + 320, LDS_BYTES = 147456;
constexpr int CW_BAR = 4096;

__device__ __forceinline__ float bf2f(unsigned short u) { return __uint_as_float((unsigned)u << 16); }
__device__ __forceinline__ unsigned f2bf(float f) { unsigned u = __float_as_uint(f); return (u + 0x7fffu + ((u >> 16) & 1u)) >> 16; }
__device__ __forceinline__ unsigned pk2(float lo, float hi) { return f2bf(lo) | (f2bf(hi) << 16); }
__device__ __forceinline__ float wave_sum(float v) {
#pragma unroll
    for (int o = 1; o < 64; o <<= 1) v += __shfl_xor(v, o);
    return v;
}
__device__ __forceinline__ int cond_of_tile(int pm) { return pm < 16 ? 0 : 1 + ((pm - 16) >> 3); }
__device__ __forceinline__ int cond_of_row(int row) { return row < M_CTX ? 0 : 1 + ((row - M_CTX) >> 11); }

__device__ __forceinline__ float sigmoid_fast(float x) { return __builtin_amdgcn_rcpf(1.0f + __builtin_amdgcn_exp2f(-LOG2E * x)); }
__device__ __forceinline__ float row_rstd(const float* SS, int row) {
    const f32x4* p = (const f32x4*)(SS + (size_t)row * 16); const f32x4 a = p[0], b = p[1], c = p[2], d = p[3];
    const float s = ((a.x + a.y) + (a.z + a.w)) + ((b.x + b.y) + (b.z + b.w)) + ((c.x + c.y) + (c.z + c.w)) + ((d.x + d.y) + (d.z + d.w));
    return 1.0f / sqrtf(s * (1.0f / D) + EPS);
}
__device__ __forceinline__ u32x4 pack8(const f32x4& a, const f32x4& b) { u32x4 w; w.x = cvt_pk_bf16(a.x, a.y); w.y = cvt_pk_bf16(a.z, a.w); w.z = cvt_pk_bf16(b.x, b.y); w.w = cvt_pk_bf16(b.z, b.w); return w; }

template <bool NORM> struct EpiSwiGLU {
    static constexpr bool PERM = true, AFTER_DRAIN = false;
    unsigned char* wsb;
    __device__ __forceinline__ void operator()(const f32x4 (&acc)[2][2][4][2], const Unit& u, int wr, int wc, int fr, int fq) const {
        bf16_t* O = (bf16_t*)(wsb + WS_ACT); const float* SS = (const float*)(wsb + WS_SS) + (size_t)M * 16; const float* B2 = (const float*)(wsb + WS_B2GU);
        const int row0 = u.pm * 256 + wr * 64 + fr, col0 = u.pn * 128 + wc * 32 + 8 * fq;
        f32x4 bg[2], bu[2]; float rs[2][4];
        if (NORM) { const float* b2 = B2 + (size_t)cond_of_tile(u.pm) * (2 * FF) + u.pn * 256 + wc * 32 + 8 * fq;
            bg[0] = *(const f32x4*)(b2); bg[1] = *(const f32x4*)(b2 + 4); bu[0] = *(const f32x4*)(b2 + 128); bu[1] = *(const f32x4*)(b2 + 132);
#pragma unroll
            for (int ai = 0; ai < 2; ++ai)
#pragma unroll
                for (int m = 0; m < 4; ++m) rs[ai][m] = row_rstd(SS, row0 + ai * 128 + m * 16); }
#pragma unroll
        for (int ai = 0; ai < 2; ++ai)
#pragma unroll
            for (int m = 0; m < 4; ++m) {
                f32x4 o[2];
#pragma unroll
                for (int n = 0; n < 2; ++n)
#pragma unroll
                    for (int j = 0; j < 4; ++j) { float g = acc[ai][0][m][n][j], up = acc[ai][1][m][n][j]; if (NORM) { g = g * rs[ai][m] + bg[n][j]; up = up * rs[ai][m] + bu[n][j]; } o[n][j] = g * up * sigmoid_fast(g); }
                *(u32x4*)(O + ((unsigned)(row0 + ai * 128 + m * 16) * (unsigned)FF + (unsigned)col0)) = pack8(o[0], o[1]);
            }
    }
};

template <int STAGE> struct EpiResid {
    static constexpr bool PERM = true, AFTER_DRAIN = false;
    const float* xp; const float* xs; float* out; unsigned char* wsb;
    __device__ __forceinline__ void operator()(const f32x4 (&acc)[2][2][4][2], const Unit& u, int wr, int wc, int fr, int fq) const {
        constexpr int gate_idx = STAGE == 0 ? 2 : STAGE == 1 ? 5 : 8; constexpr float coef = STAGE == 1 ? 1.0f : 0.5f; constexpr bool NEXT = STAGE < 2;
        const float* base_ctx = STAGE == 0 ? xp : out; const float* base_lat = STAGE == 0 ? xs : out + (size_t)M_CTX * D;
        const float* mod = (const float*)(wsb + WS_MOD); bf16_t* HN = (bf16_t*)(wsb + WS_H2);
        const float* gs = (const float*)(wsb + WS_GS) + (STAGE == 1 ? NCOND * D : 0); float* SS = (float*)(wsb + WS_SS) + (STAGE == 1 ? (size_t)M * 16 : 0);
        const int row0 = u.pm * 256 + wr * 64 + fr, col0 = u.pn * 256 + wc * 32 + 8 * fq, cnd = cond_of_tile(u.pm);
        const float* gate = mod + (size_t)cnd * MODW + gate_idx * D + col0;
        f32x4 gv[2][2], sv[2][2];
#pragma unroll
        for (int bj = 0; bj < 2; ++bj)
#pragma unroll
            for (int n = 0; n < 2; ++n) { gv[bj][n] = *(const f32x4*)(gate + bj * 128 + n * 4) * coef; if (NEXT) sv[bj][n] = *(const f32x4*)(gs + (size_t)cnd * D + col0 + bj * 128 + n * 4); }
#pragma unroll
        for (int ai = 0; ai < 2; ++ai)
#pragma unroll
            for (int mh = 0; mh < 2; ++mh) {
                f32x4 pre[2][2][2];
#pragma unroll
                for (int mm = 0; mm < 2; ++mm) { const int row = row0 + ai * 128 + (2 * mh + mm) * 16;
                    const float* bp = (row < M_CTX ? base_ctx + ((unsigned)row * (unsigned)D + (unsigned)col0) : base_lat + ((unsigned)(row - M_CTX) * (unsigned)D + (unsigned)col0));
#pragma unroll
                    for (int bj = 0; bj < 2; ++bj)
#pragma unroll
                        for (int n = 0; n < 2; ++n) pre[mm][bj][n] = *(const f32x4*)(bp + bj * 128 + n * 4); }
#pragma unroll
                for (int mm = 0; mm < 2; ++mm) { const int m = 2 * mh + mm, row = row0 + ai * 128 + m * 16;
                    const unsigned eo = (unsigned)row * (unsigned)D + (unsigned)col0; float* op = out + eo; float s2 = 0.f;
#pragma unroll
                    for (int bj = 0; bj < 2; ++bj) {
                        const f32x4 v0 = pre[mm][bj][0] + gv[bj][0] * acc[ai][bj][m][0], v1 = pre[mm][bj][1] + gv[bj][1] * acc[ai][bj][m][1];
                        *(f32x4*)(op + bj * 128) = v0; *(f32x4*)(op + bj * 128 + 4) = v1;
                        if (NEXT) { s2 += ((v0.x * v0.x + v0.y * v0.y) + (v0.z * v0.z + v0.w * v0.w)) + ((v1.x * v1.x + v1.y * v1.y) + (v1.z * v1.z + v1.w * v1.w));
                                    *(u32x4*)(HN + eo + bj * 128) = pack8(v0 * sv[bj][0], v1 * sv[bj][1]); } }
                    if (NEXT) { s2 += __shfl_xor(s2, 16); s2 += __shfl_xor(s2, 32); if (fq == 0) SS[(size_t)row * 16 + u.pn * 4 + wc] = s2; } }
            }
    }
};

struct EpiIn {
    static constexpr bool PERM = true, AFTER_DRAIN = false;
    unsigned char* wsb; float* outp; LAS unsigned char* ropel;
    template <int MODE> __device__ __forceinline__ void half(const f32x4 (&acc)[2][2][4][2], const float (&rs)[2][4], int pn, int bj, int pm, int wr, int wc, int fr, int fq, bf16_t* dst, int ld, int dcol, float* fdst, float qs) const {
        const int row0 = pm * 256 + wr * 64 + fr, c0 = dcol + wc * 32 + 8 * fq;
        const bool lat = pm >= 16;
        const float* b2 = (const float*)(wsb + WS_B2IN) + (size_t)cond_of_tile(pm) * NIN + pn * 256 + bj * 128 + wc * 32 + 8 * fq;
        const f32x4 b2a = *(const f32x4*)b2, b2b = *(const f32x4*)(b2 + 4);
        const LAS f32x4* rope = (const LAS f32x4*)ropel;
#pragma unroll
        for (int ai = 0; ai < 2; ++ai) {
#pragma unroll
            for (int m = 0; m < 4; ++m) {
                const int row = row0 + ai * 128 + m * 16;
                f32x4 v0 = acc[ai][bj][m][0] * rs[ai][m] + b2a, v1 = acc[ai][bj][m][1] * rs[ai][m] + b2b;
                const unsigned eoff = (unsigned)row * (unsigned)ld + (unsigned)c0;
                if (fdst && !lat) { *(f32x4*)(fdst + eoff) = v0; *(f32x4*)(fdst + eoff + 4) = v1; }
                if (MODE == 1 && lat) {
                    const float sgn = (fq & 2) ? 1.0f : -1.0f;
                    const int t = (row - M_CTX) & (LAT_N - 1), pos = (wc & 1) ? (t & 63) : (t >> 6);
                    f32x4 cs[4];
#pragma unroll
                    for (int q = 0; q < 4; ++q) cs[q] = rope[pos * 8 + 4 * (fq & 1) + q];
                    f32x4 w0, w1;
#pragma unroll
                    for (int j = 0; j < 4; ++j) {
                        const float o0 = __shfl_xor(v0[j], 32), o1 = __shfl_xor(v1[j], 32);
                        const float c0_ = cs[j >> 1][2 * (j & 1)], s0_ = cs[j >> 1][2 * (j & 1) + 1];
                        const float c1_ = cs[2 + (j >> 1)][2 * (j & 1)], s1_ = cs[2 + (j >> 1)][2 * (j & 1) + 1];
                        w0[j] = v0[j] * c0_ + sgn * o0 * s0_; w1[j] = v1[j] * c1_ + sgn * o1 * s1_; }
                    v0 = w0; v1 = w1;
                }
                if (MODE == 2) {
#pragma unroll
                    for (int j = 0; j < 4; ++j) { v0[j] = sigmoid_fast(v0[j]); v1[j] = sigmoid_fast(v1[j]); }
                }
                *(u32x4*)(dst + eoff) = pack8(v0 * qs, v1 * qs);
            }
        }
    }
    __device__ __forceinline__ void operator()(const f32x4 (&acc)[2][2][4][2], const Unit& u, int wr, int wc, int fr, int fq) const {
        const int pn = u.pn, pm = u.pm;
        bf16_t* QAB = (bf16_t*)(wsb + WS_QAB); bf16_t* KA = (bf16_t*)(wsb + WS_KA); bf16_t* VA = (bf16_t*)(wsb + WS_VA); bf16_t* KB = (bf16_t*)(wsb + WS_KB); bf16_t* VB = (bf16_t*)(wsb + WS_VB);
        bf16_t* SGNA = (bf16_t*)(wsb + WS_SGNA); bf16_t* SGSWA = (bf16_t*)(wsb + WS_SGSWA); const float* SS = (const float*)(wsb + WS_SS);
        float* o_nak = outp + OUT_NAK; float* o_nav = outp + OUT_NAV; float* o_swk = outp + OUT_SWK; float* o_swv = outp + OUT_SWV;
        float rs[2][4];
#pragma unroll
        for (int ai = 0; ai < 2; ++ai)
#pragma unroll
            for (int m = 0; m < 4; ++m) rs[ai][m] = row_rstd(SS, pm * 256 + wr * 64 + fr + ai * 128 + m * 16);
#define HALF_(MODE, bj, dst, ld, dcol, fdst, qs) half<MODE>(acc, rs, pn, bj, pm, wr, wc, fr, fq, dst, ld, dcol, fdst, qs)
        if (pn < 2)       { HALF_(0, 0, QAB, 1024, 256 * pn, nullptr, QSCALE);             asm volatile("" ::: "memory"); HALF_(0, 1, QAB, 1024, 256 * pn + 128, nullptr, QSCALE); }
        else if (pn < 4)  { HALF_(0, 0, KA, 512, 256 * (pn - 2), o_nak, 1.0f);             asm volatile("" ::: "memory"); HALF_(0, 1, KA, 512, 256 * (pn - 2) + 128, o_nak, 1.0f); }
        else if (pn < 6)  { HALF_(0, 0, VA, 512, 256 * (pn - 4), o_nav, 1.0f);             asm volatile("" ::: "memory"); HALF_(0, 1, VA, 512, 256 * (pn - 4) + 128, o_nav, 1.0f); }
        else if (pn < 8)  { HALF_(1, 0, QAB, 1024, 512 + 256 * (pn - 6), nullptr, QSCALE); asm volatile("" ::: "memory"); HALF_(1, 1, QAB, 1024, 512 + 256 * (pn - 6) + 128, nullptr, QSCALE); }
        else if (pn == 8) { HALF_(1, 0, KB, 128, 0, o_swk, 1.0f);                          asm volatile("" ::: "memory"); HALF_(0, 1, VB, 128, 0, o_swv, 1.0f); }
        else if (pn < 13) { HALF_(2, 0, SGNA, 1024, 256 * (pn - 9), nullptr, 1.0f);        asm volatile("" ::: "memory"); HALF_(2, 1, SGNA, 1024, 256 * (pn - 9) + 128, nullptr, 1.0f); }
        else              { HALF_(2, 0, SGSWA, 1024, 256 * (pn - 13), nullptr, 1.0f);      asm volatile("" ::: "memory"); HALF_(2, 1, SGSWA, 1024, 256 * (pn - 13) + 128, nullptr, 1.0f); }
#undef HALF_
    }
};

template <bool SECOND> struct EpiMerge {
    static constexpr bool PERM = true, AFTER_DRAIN = false;
    unsigned char* wsb;
    __device__ __forceinline__ void operator()(const f32x4 (&acc)[2][2][4][2], const Unit& u, int wr, int wc, int fr, int fq) const {
        const bf16_t* SG = (const bf16_t*)(wsb + (SECOND ? WS_SGSWA : WS_SGNA)); const bf16_t* TMPIN = (const bf16_t*)(wsb + WS_TMP); bf16_t* O = (bf16_t*)(wsb + (SECOND ? WS_H : WS_TMP));
        const int row0 = u.pm * 256 + wr * 64 + fr, col0 = u.pn * 256 + wc * 32 + 8 * fq;
#pragma unroll
        for (int ai = 0; ai < 2; ++ai) {
            u32x4 sg[4][2], tp[4][2];
#pragma unroll
            for (int m = 0; m < 4; ++m)
#pragma unroll
                for (int bj = 0; bj < 2; ++bj) { const unsigned off = (unsigned)(row0 + ai * 128 + m * 16) * (unsigned)D + (unsigned)(col0 + bj * 128);
                    sg[m][bj] = *(const u32x4*)(SG + off); if (SECOND) tp[m][bj] = *(const u32x4*)(TMPIN + off); else tp[m][bj] = (u32x4){0u, 0u, 0u, 0u}; }
#pragma unroll
            for (int m = 0; m < 4; ++m)
#pragma unroll
                for (int bj = 0; bj < 2; ++bj) {
                    const unsigned off = (unsigned)(row0 + ai * 128 + m * 16) * (unsigned)D + (unsigned)(col0 + bj * 128);
                    f32x4 o[2];
#pragma unroll
                    for (int n = 0; n < 2; ++n)
#pragma unroll
                        for (int j = 0; j < 4; ++j) {
                            const int e = 4 * n + j; const unsigned sw = sg[m][bj][e >> 1], tw = tp[m][bj][e >> 1];
                            const float s = (e & 1) ? __uint_as_float(sw & 0xffff0000u) : __uint_as_float(sw << 16);
                            const float t = (e & 1) ? __uint_as_float(tw & 0xffff0000u) : __uint_as_float(tw << 16);
                            o[n][j] = t + s * acc[ai][bj][m][n][j];
                        }
                    *(u32x4*)(O + off) = pack8(o[0], o[1]);
                }
        }
    }
};

struct Ctx {
    LAS unsigned char* lds; int tid, lane, wave, vcu, G;
};

constexpr int TR_ROWB = 144;
__device__ __forceinline__ void transpose_item(const float* W, int N, bf16_t* WT, int ldt, int koff, int drow0, LAS unsigned char* scr, int kb, int nb, int lane) {
    const int k0 = 64 * kb, n0 = 64 * nb, kr = lane >> 4, nq = lane & 15;
    const float* src = W + (size_t)(k0 + 16 * kr) * N + n0 + 4 * nq;
    f32x4 v[16];
#pragma unroll
    for (int i = 0; i < 16; ++i) v[i] = *(const f32x4*)(src + (size_t)i * N);
#pragma unroll
    for (int e = 0; e < 4; ++e) {
        u32x4 lo, hi;
        lo.x = cvt_pk_bf16(v[0][e], v[1][e]); lo.y = cvt_pk_bf16(v[2][e], v[3][e]); lo.z = cvt_pk_bf16(v[4][e], v[5][e]); lo.w = cvt_pk_bf16(v[6][e], v[7][e]);
        hi.x = cvt_pk_bf16(v[8][e], v[9][e]); hi.y = cvt_pk_bf16(v[10][e], v[11][e]); hi.z = cvt_pk_bf16(v[12][e], v[13][e]); hi.w = cvt_pk_bf16(v[14][e], v[15][e]);
        LAS unsigned char* p = scr + (4 * nq + e) * TR_ROWB + 32 * kr;
        *(LAS u32x4*)p = lo; *(LAS u32x4*)(p + 16) = hi;
    }
    asm volatile("s_waitcnt lgkmcnt(0)" ::: "memory");
#pragma unroll
    for (int j = 0; j < 8; ++j) { const int row = 8 * j + (lane >> 3), ch = lane & 7;
        const u32x4 o = *(const LAS u32x4*)(scr + row * TR_ROWB + 16 * ch);
        *(u32x4*)(WT + (size_t)(drow0 + row) * ldt + koff + k0 + 8 * ch) = o; }
    asm volatile("s_waitcnt lgkmcnt(0)" ::: "memory");
}
__device__ __forceinline__ void tr_plain(const float* W, int K, int N, bf16_t* WT, int ldt, int koff, LAS unsigned char* scr, int item, int lane) {
    const int nblk = N / 64, kb = item / nblk, nb = item % nblk; (void)K;
    transpose_item(W, N, WT, ldt, koff, 64 * nb, scr, kb, nb, lane);
}
__device__ __forceinline__ void tr_gu(const float* W, bf16_t* WT, int up, LAS unsigned char* scr, int item, int lane) {
    const int nblk = FF / 64, kb = item / nblk, nb = item % nblk, n0 = 64 * nb;
    transpose_item(W, FF, WT, D, 0, (n0 >> 7) * 256 + (n0 & 127) + up * 128, scr, kb, nb, lane);
}
constexpr int I_GU = (D / 64) * (FF / 64), I_DN = (FF / 64) * (D / 64), I_IN = (D / 64) * (NIN / 64), I_BR = (512 / 64) * (D / 64), I_OUT = (D / 64) * (D / 64);
constexpr int I_ALL = 2 * (2 * I_GU + I_DN) + I_IN + 2 * I_BR + I_OUT;

template <bool FINAL> __device__ __forceinline__ void norm_rows(const float* xp, const float* xs, void* outp, const float* g, const float* mod, int sc_idx, int sh_idx, int row0, int stride, int lane) {
    f32x4 v[4], nv[4];
    if (row0 < M) { const f32x4* xr = (const f32x4*)(row0 < M_CTX ? xp + (size_t)row0 * D : xs + (size_t)(row0 - M_CTX) * D) + lane;
#pragma unroll
        for (int j = 0; j < 4; ++j) v[j] = xr[64 * j]; }
    for (int row = row0; row < M; row += stride) {
        const int nrow = row + stride;
        if (nrow < M) { const f32x4* xr = (const f32x4*)(nrow < M_CTX ? xp + (size_t)nrow * D : xs + (size_t)(nrow - M_CTX) * D) + lane;
#pragma unroll
            for (int j = 0; j < 4; ++j) nv[j] = xr[64 * j]; }
        float s2 = 0.f;
#pragma unroll
        for (int j = 0; j < 4; ++j) s2 += (v[j].x * v[j].x + v[j].y * v[j].y) + (v[j].z * v[j].z + v[j].w * v[j].w);
        const float rstd = 1.0f / sqrtf(wave_sum(s2) * (1.0f / D) + EPS);
        const float* md = mod + (size_t)cond_of_row(row) * MODW;
#pragma unroll
        for (int j = 0; j < 4; ++j) {
            const f32x4 gv = ((const f32x4*)g)[64 * j + lane];
            f32x4 o = v[j] * rstd * gv;
            if (FINAL) { ((f32x4*)outp)[(size_t)row * (D / 4) + 64 * j + lane] = o; }
            else {
                const f32x4 scv = ((const f32x4*)(md + sc_idx * D))[64 * j + lane], shv = ((const f32x4*)(md + sh_idx * D))[64 * j + lane];
                o = o * (scv + 1.0f) + shv;
                u32x2 w; w.x = cvt_pk_bf16(o.x, o.y); w.y = cvt_pk_bf16(o.z, o.w);
                ((u32x2*)outp)[(size_t)row * (D / 4) + 64 * j + lane] = w;
            }
        }
#pragma unroll
        for (int j = 0; j < 4; ++j) v[j] = nv[j];
    }
}

struct AttnBufs { bf16_t *OB; bf16_t *QAB; const bf16_t *KA, *VA, *KB, *VB, *CKNA, *CVNA, *CKSWA, *CVSWA; const float* relb; const float* sink; };

#define ATT_STEP(KP, VP, BIAS2, VALID) do { if (VALID) { \
        const u32x4* kp_ = (const u32x4*)(KP); float s_ = (BIAS2); \
        _Pragma("unroll") for (int c_ = 0; c_ < 8; ++c_) { const u32x4 kk_ = kp_[c_]; \
            _Pragma("unroll") for (int e_ = 0; e_ < 4; ++e_) { s_ += q[8 * c_ + 2 * e_] * __uint_as_float(kk_[e_] << 16) + q[8 * c_ + 2 * e_ + 1] * __uint_as_float(kk_[e_] & 0xffff0000u); } } \
        if (s_ > mx) { const float al_ = exp2f(mx - s_); l *= al_; _Pragma("unroll") for (int d_ = 0; d_ < 64; ++d_) o[d_] *= al_; mx = s_; } \
        const float p_ = exp2f(s_ - mx); l += p_; \
        const u32x4* vp_ = (const u32x4*)(VP); \
        _Pragma("unroll") for (int c_ = 0; c_ < 8; ++c_) { const u32x4 vv_ = vp_[c_]; \
            _Pragma("unroll") for (int e_ = 0; e_ < 4; ++e_) { o[8 * c_ + 2 * e_] += p_ * __uint_as_float(vv_[e_] << 16); o[8 * c_ + 2 * e_ + 1] += p_ * __uint_as_float(vv_[e_] & 0xffff0000u); } } \
    } } while (0)

__device__ __forceinline__ void attn_naive_item(const AttnBufs& A, int kind, int b, int head, int chunk, int lane) {
    const bool lat = kind >= 2, swa = kind & 1;
    const int t = chunk * 64 + lane;
    const int row = lat ? M_CTX + b * LAT_N + t : b * CTX_L + t;
    const int qcol = swa ? 512 + head * 64 : head * 64;
    bf16_t* qp = A.QAB + (size_t)row * 1024 + qcol;
    float q[64], o[64];
#pragma unroll
    for (int c = 0; c < 8; ++c) { const u32x4 w = ((const u32x4*)qp)[c];
#pragma unroll
        for (int e = 0; e < 4; ++e) { q[8 * c + 2 * e] = __uint_as_float(w[e] << 16); q[8 * c + 2 * e + 1] = __uint_as_float(w[e] & 0xffff0000u); } }
#pragma unroll
    for (int d = 0; d < 64; ++d) o[d] = 0.f;
    float mx = -1e30f, l = 0.f;
    if (swa) { mx = A.sink[head] * LOG2E; l = 1.f; }
    const int kvh = head >> 2;
    if (!lat) {
        const bf16_t* kb_ = swa ? A.KB + (size_t)(b * CTX_L) * 128 + kvh * 64 : A.KA + (size_t)(b * CTX_L) * 512 + head * 64;
        const bf16_t* vb_ = swa ? A.VB + (size_t)(b * CTX_L) * 128 + kvh * 64 : A.VA + (size_t)(b * CTX_L) * 512 + head * 64;
        const int ld = swa ? 128 : 512;
        for (int j = 0; j < CTX_L; ++j) ATT_STEP(kb_ + (size_t)j * ld, vb_ + (size_t)j * ld, 0.f, true);
    } else if (!swa) {
        const int r = t >> 6, c = t & 63;
        const int rs = min(max(r - 4, 0), 24), cs = min(max(c - 8, 0), 48);
        const bf16_t* kb_ = A.KA + (size_t)(M_CTX + b * LAT_N) * 512 + head * 64;
        const bf16_t* vb_ = A.VA + (size_t)(M_CTX + b * LAT_N) * 512 + head * 64;
        const float* rb = A.relb + head * (15 * 31);
        for (int i = 0; i < 8; ++i)
            for (int j = 0; j < 16; ++j) {
                const int kt = (rs + i) * 64 + cs + j;
                const float bias = rb[(rs + i - r + 7) * 31 + (cs + j - c + 15)] * LOG2E;
                ATT_STEP(kb_ + (size_t)kt * 512, vb_ + (size_t)kt * 512, bias, true);
            }
        const bf16_t* ck = A.CKNA + (size_t)(b * PAST) * 512 + head * 64; const bf16_t* cv = A.CVNA + (size_t)(b * PAST) * 512 + head * 64;
        for (int j = 0; j < PAST; ++j) ATT_STEP(ck + (size_t)j * 512, cv + (size_t)j * 512, 0.f, true);
    } else {
        const bf16_t* kb_ = A.KB + (size_t)(M_CTX + b * LAT_N) * 128 + kvh * 64;
        const bf16_t* vb_ = A.VB + (size_t)(M_CTX + b * LAT_N) * 128 + kvh * 64;
        const int t0 = chunk * 64, jlo = max(0, t0 - 128), jhi = min(LAT_N - 1, t0 + 63 + 128);
        for (int j = jlo; j <= jhi; ++j) { const int dj = j - t; ATT_STEP(kb_ + (size_t)j * 128, vb_ + (size_t)j * 128, 0.f, (dj <= 128 && dj >= -128)); }
        const bf16_t* ck = A.CKSWA + (size_t)(b * PAST) * 128 + kvh * 64; const bf16_t* cv = A.CVSWA + (size_t)(b * PAST) * 128 + kvh * 64;
        for (int j = 0; j < PAST; ++j) ATT_STEP(ck + (size_t)j * 128, cv + (size_t)j * 128, 0.f, true);
    }
    const float rl = 1.0f / l;
#pragma unroll
    for (int c = 0; c < 8; ++c) { u32x4 w;
#pragma unroll
        for (int e = 0; e < 4; ++e) w[e] = pk2(o[8 * c + 2 * e] * rl, o[8 * c + 2 * e + 1] * rl);
        ((u32x4*)qp)[c] = w; }
}
__device__ __forceinline__ void attn_naive_phase(const Ctx& F, const AttnBufs& A) {
    const int gw = F.vcu * NWAVES + F.wave, NGW = F.G * NWAVES;
    for (int it = gw; it < 4096 + 1024; it += NGW) {
        if (it < 4096) { const int chunk = it & 31, hh = (it >> 5) & 15, b = it >> 9; attn_naive_item(A, 2 + (hh >> 3), b, hh & 7, chunk, F.lane); }
        else { const int r = it - 4096, chunk = r & 3, hh = (r >> 2) & 15, b = r >> 6; attn_naive_item(A, hh >> 3, b, hh & 7, chunk, F.lane); }
    }
}


namespace att {
typedef short bf16x8 __attribute__((ext_vector_type(8)));
typedef short s16x4 __attribute__((ext_vector_type(4)));
typedef float f32x16 __attribute__((ext_vector_type(16)));
typedef float f32x2_t __attribute__((ext_vector_type(2))); typedef __bf16 bf16x2_t __attribute__((ext_vector_type(2)));
constexpr int A_K = 0, A_V = 16384, A_WSF = 32768, A_OST = 34816, A_TB = 67584, TB_ROW = 132, TB_FLOATS = 4 * 15 * TB_ROW;
static_assert(A_TB + TB_FLOATS * 4 <= RING_BYTES, "attention LDS map");
__device__ __forceinline__ int crow(int r, int hi) { return (r & 3) + 8 * (r >> 2) + 4 * hi; }
__device__ __forceinline__ unsigned cvtpk_s(float lo, float hi) { f32x2_t v = {lo, hi}; bf16x2_t b = __builtin_convertvector(v, bf16x2_t); return __builtin_bit_cast(unsigned, b); }
__device__ __forceinline__ s16x4 vtr(const LAS unsigned char* p) { typedef short v4i16_t __attribute__((ext_vector_type(4))); return __builtin_bit_cast(s16x4, __builtin_amdgcn_ds_read_tr16_b64_v4i16((LAS v4i16_t*)p)); }
__device__ __forceinline__ float halves_max(float m) { auto rr = __builtin_amdgcn_permlane32_swap(__float_as_uint(m), __float_as_uint(m), false, false); return fmaxf(__uint_as_float(rr[0]), __uint_as_float(rr[1])); }
__device__ __forceinline__ float halves_sum(float m) { auto rr = __builtin_amdgcn_permlane32_swap(__float_as_uint(m), __float_as_uint(m), false, false); return __uint_as_float(rr[0]) + __uint_as_float(rr[1]); }

template <int KIND>
__device__ __forceinline__ void attn_unit(LAS unsigned char* lds, const AttnBufs& A, int ub, int uh, int ux, int lane, int wid) {
    constexpr bool LAT = KIND >= 2, SWA = (KIND & 1) != 0, NA_LAT = KIND == 2, SWA_LAT = KIND == 3;
    const int r32 = lane & 31, hi = lane >> 5;
    int qrow0, qcol, ldk, NB, NT; const bf16_t *Kb, *Vb, *Kc, *Vc;
    int wlo = 0, whi = 1 << 30, dr0 = 0, cq = 0, qpos0 = 0, kt00 = 0, head = uh;
    if (KIND == 0) { qrow0 = ub * CTX_L + 32 * wid; qcol = uh * 64; ldk = 512; NB = 4; NT = 4;
        Kb = A.KA + (size_t)(ub * CTX_L) * 512 + uh * 64; Vb = A.VA + (size_t)(ub * CTX_L) * 512 + uh * 64; Kc = Kb; Vc = Vb; }
    else if (KIND == 1) { qrow0 = ub * CTX_L + 32 * wid; qcol = 512 + uh * 64; ldk = 128; NB = 4; NT = 4;
        Kb = A.KB + (size_t)(ub * CTX_L) * 128 + (uh >> 2) * 64; Vb = A.VB + (size_t)(ub * CTX_L) * 128 + (uh >> 2) * 64; Kc = Kb; Vc = Vb; }
    else if (KIND == 2) {
        const int r0 = 4 * ux, rw = r0 + (wid >> 1), c0 = 32 * (wid & 1);
        const int kr_lo = min(max(r0 - 4, 0), 24), kr_hi = min(max(r0 + 3 - 4, 0), 24) + 7, rs_w = min(max(rw - 4, 0), 24);
        qrow0 = M_CTX + ub * LAT_N + rw * 64 + c0; qcol = uh * 64; ldk = 512; NB = kr_hi - kr_lo + 1; NT = NB + 4;
        wlo = rs_w - kr_lo; whi = wlo + 7; dr0 = kr_lo - rw + 7; cq = c0 + r32;
        Kb = A.KA + (size_t)(M_CTX + ub * LAT_N + kr_lo * 64) * 512 + uh * 64; Vb = A.VA + (size_t)(M_CTX + ub * LAT_N + kr_lo * 64) * 512 + uh * 64;
        Kc = A.CKNA + (size_t)(ub * PAST) * 512 + uh * 64; Vc = A.CVNA + (size_t)(ub * PAST) * 512 + uh * 64; }
    else {
        head = 4 * uh + (wid >> 1); const int tb0 = max(0, ux - 2), tb1 = min(31, ux + 2);
        qpos0 = 64 * ux + 32 * (wid & 1); kt00 = 64 * tb0;
        qrow0 = M_CTX + ub * LAT_N + qpos0; qcol = 512 + head * 64; ldk = 128; NB = tb1 - tb0 + 1; NT = NB + 4;
        Kb = A.KB + (size_t)(M_CTX + ub * LAT_N + kt00) * 128 + uh * 64; Vb = A.VB + (size_t)(M_CTX + ub * LAT_N + kt00) * 128 + uh * 64;
        Kc = A.CKSWA + (size_t)(ub * PAST) * 128 + uh * 64; Vc = A.CVSWA + (size_t)(ub * PAST) * 128 + uh * 64; }
    LAS float* TB = (LAS float*)(lds + A_TB);
    if (NA_LAT) {
        const float* rb = A.relb + uh * (15 * 31);
        for (int idx = threadIdx.x; idx < TB_FLOATS; idx += NWAVES * 64) { const int s = idx / (15 * TB_ROW), rem = idx - s * (15 * TB_ROW), dr = rem / TB_ROW, i = rem - dr * TB_ROW, dc = i - 48 - s;
            TB[idx] = (dc >= 0 && dc <= 30) ? rb[dr * 31 + dc] * LOG2E : 0.f; }
    }
    bf16_t* Qw = A.QAB + (size_t)qrow0 * 1024 + qcol;
    bf16x8 qr[4];
#pragma unroll
    for (int d0 = 0; d0 < 4; ++d0) qr[d0] = *(const bf16x8*)(Qw + (size_t)r32 * 1024 + d0 * 16 + hi * 8);
    float mhat = 0.f, lsum = 0.f;
    if (SWA) { mhat = A.sink[head] * LOG2E; lsum = (hi == 0) ? 1.f : 0.f; }
    f32x16 o0, o1;
#pragma unroll
    for (int r = 0; r < 16; ++r) { o0[r] = 0.f; o1[r] = 0.f; }
    unsigned vmask = 0u;
    int lane_tb = 0;
    if (NA_LAT) {
        const int cs = min(max(cq - 8, 0), 48), s = (cq + 1) & 3;
#pragma unroll
        for (int r = 0; r < 16; ++r) { const int kc = crow(r, hi); vmask |= (kc >= cs && kc < cs + 16) ? (1u << r) : 0u; vmask |= (kc + 32 >= cs && kc + 32 < cs + 16) ? (1u << (16 + r)) : 0u; }
        lane_tb = s * 15 * TB_ROW + (63 - cq + s) + 4 * hi;
    }
    LAS float* wsf = (LAS float*)(lds + A_WSF) + wid * 64;
    const size_t koff = (size_t)lane * ldk + wid * 8, voff = (size_t)(16 * (wid & 3) + (lane >> 2)) * ldk + (wid >> 2) * 32 + (lane & 3) * 8;
    const int st_off = wid * 1024 + lane * 16;
    { const u32x4 kreg = *(const u32x4*)(Kb + koff), vreg = *(const u32x4*)(Vb + voff);
      *(LAS u32x4*)(lds + A_K + st_off) = kreg; *(LAS u32x4*)(lds + A_V + st_off) = vreg; }
    __syncthreads();
    for (int t = 0; t < NT; ++t) {
        const int buf = t & 1;
        u32x4 kreg = (u32x4){0u, 0u, 0u, 0u}, vreg = (u32x4){0u, 0u, 0u, 0u};
        if (t + 1 < NT) { const bf16_t* kt = (t + 1 < NB) ? Kb + (size_t)(t + 1) * 64 * ldk : Kc + (size_t)(t + 1 - NB) * 64 * ldk;
                          const bf16_t* vt = (t + 1 < NB) ? Vb + (size_t)(t + 1) * 64 * ldk : Vc + (size_t)(t + 1 - NB) * 64 * ldk;
                          kreg = *(const u32x4*)(kt + koff); vreg = *(const u32x4*)(vt + voff); }
        const bool band = LAT && t < NB;
        if (!(NA_LAT && band && (t < wlo || t > whi))) {
            const LAS unsigned char* kp = lds + A_K + buf * 8192 + hi * 1024 + r32 * 16;
            bf16x8 kf[8];
#pragma unroll
            for (int d0 = 0; d0 < 4; ++d0) { kf[2 * d0] = *(const LAS bf16x8*)(kp + d0 * 2048); kf[2 * d0 + 1] = *(const LAS bf16x8*)(kp + d0 * 2048 + 512); }
            f32x16 p0, p1;
            if (NA_LAT && band) {
                const LAS float* tb = TB + (dr0 + t) * TB_ROW + lane_tb;
#pragma unroll
                for (int g = 0; g < 4; ++g) { const f32x4 b0 = *(const LAS f32x4*)(tb + 8 * g), b1 = *(const LAS f32x4*)(tb + 8 * g + 32);
#pragma unroll
                    for (int e = 0; e < 4; ++e) { p0[4 * g + e] = ((vmask >> (4 * g + e)) & 1u) ? b0[e] - mhat : -1e30f; p1[4 * g + e] = ((vmask >> (16 + 4 * g + e)) & 1u) ? b1[e] - mhat : -1e30f; } }
            } else {
#pragma unroll
                for (int r = 0; r < 16; ++r) { p0[r] = -mhat; p1[r] = -mhat; }
            }
#pragma unroll
            for (int d0 = 0; d0 < 4; ++d0) { p0 = __builtin_amdgcn_mfma_f32_32x32x16_bf16(kf[2 * d0], qr[d0], p0, 0, 0, 0); p1 = __builtin_amdgcn_mfma_f32_32x32x16_bf16(kf[2 * d0 + 1], qr[d0], p1, 0, 0, 0); }
            if (SWA_LAT && band) {
                const int dl0 = kt00 + 64 * t - qpos0;
                if (dl0 - 31 < -128 || dl0 + 63 > 128) {
                    const int dlt = dl0 - r32 + 4 * hi;
#pragma unroll
                    for (int r = 0; r < 16; ++r) { const int d_ = dlt + crow(r, 0); if (d_ < -128 || d_ > 128) p0[r] = -1e30f; if (d_ + 32 < -128 || d_ + 32 > 128) p1[r] = -1e30f; }
                }
            }
            float rm = fmaxf(p0[0], p1[0]);
#pragma unroll
            for (int r = 1; r < 16; ++r) rm = fmaxf(rm, fmaxf(p0[r], p1[r]));
            rm = halves_max(rm);
            if (__any(rm > 0.f)) {
                const float dl = fmaxf(rm, 0.f); mhat += dl;
                const float f = __builtin_amdgcn_exp2f(-dl); lsum *= f;
#pragma unroll
                for (int r = 0; r < 16; ++r) { p0[r] -= dl; p1[r] -= dl; }
                if (hi == 0) wsf[r32] = f;
#pragma unroll
                for (int g = 0; g < 4; ++g) { const f32x4 fv = *(const LAS f32x4*)(wsf + 8 * g + 4 * hi);
#pragma unroll
                    for (int e = 0; e < 4; ++e) { o0[4 * g + e] *= fv[e]; o1[4 * g + e] *= fv[e]; } }
            }
            float sacc = 0.f;
#pragma unroll
            for (int r = 0; r < 16; ++r) { p0[r] = __builtin_amdgcn_exp2f(p0[r]); p1[r] = __builtin_amdgcn_exp2f(p1[r]); sacc += p0[r] + p1[r]; }
            lsum += sacc;
            u32x4 pw[4];
#pragma unroll
            for (int i = 0; i < 4; ++i) { pw[0][i] = cvtpk_s(p0[2 * i], p0[2 * i + 1]); pw[1][i] = cvtpk_s(p0[8 + 2 * i], p0[8 + 2 * i + 1]); pw[2][i] = cvtpk_s(p1[2 * i], p1[2 * i + 1]); pw[3][i] = cvtpk_s(p1[8 + 2 * i], p1[8 + 2 * i + 1]); }
            const LAS unsigned char* vp = lds + A_V + buf * 8192 + ((lane >> 4) & 1) * 32 + (lane & 3) * 8 + (4 * hi + ((lane & 15) >> 2)) * 64;
#pragma unroll
            for (int ks = 0; ks < 4; ++ks) {
                const s16x4 a0 = vtr(vp + ks * 1024), a1 = vtr(vp + ks * 1024 + 512), b0 = vtr(vp + 4096 + ks * 1024), b1 = vtr(vp + 4096 + ks * 1024 + 512);
                const bf16x8 v0 = (bf16x8){a0[0], a0[1], a0[2], a0[3], a1[0], a1[1], a1[2], a1[3]}, v1 = (bf16x8){b0[0], b0[1], b0[2], b0[3], b1[0], b1[1], b1[2], b1[3]};
                const bf16x8 pa = __builtin_bit_cast(bf16x8, pw[ks]);
                o0 = __builtin_amdgcn_mfma_f32_32x32x16_bf16(pa, v0, o0, 0, 0, 0);
                o1 = __builtin_amdgcn_mfma_f32_32x32x16_bf16(pa, v1, o1, 0, 0, 0);
            }
        }
        if (t + 1 < NT) { *(LAS u32x4*)(lds + A_K + (buf ^ 1) * 8192 + st_off) = kreg; *(LAS u32x4*)(lds + A_V + (buf ^ 1) * 8192 + st_off) = vreg; }
        __syncthreads();
    }
    const float ltot = halves_sum(lsum);
    if (hi == 0) wsf[32 + r32] = 1.0f / ltot;
    bf16_t* stg = (bf16_t*)nullptr; LAS bf16_t* sg = (LAS bf16_t*)(lds + A_OST + wid * 4096); (void)stg;
#pragma unroll
    for (int g = 0; g < 4; ++g) { const f32x4 rl = *(const LAS f32x4*)(wsf + 32 + 8 * g + 4 * hi);
#pragma unroll
        for (int e = 0; e < 4; ++e) { const int orow = 8 * g + 4 * hi + e;
            sg[orow * 64 + r32] = (bf16_t)f2bf(o0[4 * g + e] * rl[e]); sg[orow * 64 + 32 + r32] = (bf16_t)f2bf(o1[4 * g + e] * rl[e]); } }
#pragma unroll
    for (int i = 0; i < 4; ++i) { const int row = i * 8 + (lane >> 3), ch = lane & 7; const u32x4 v = *(const LAS u32x4*)(sg + row * 64 + ch * 8); *(u32x4*)(A.OB + (size_t)(qrow0 + row) * 1024 + qcol + ch * 8) = v; }
}

__device__ __forceinline__ void attn_phase(const Ctx& F, const AttnBufs& A) {
    for (int u = F.vcu; u < 1280; u += F.G) {
        if (u < 512) attn_unit<2>(F.lds, A, u >> 6, (u >> 3) & 7, u & 7, F.lane, F.wave);
        else if (u < 1024) { const int v = u - 512; attn_unit<3>(F.lds, A, v >> 6, (v >> 5) & 1, v & 31, F.lane, F.wave); }
        else if (u < 1152) { const int v = u - 1024; attn_unit<0>(F.lds, A, v >> 3, v & 7, 0, F.lane, F.wave); }
        else { const int v = u - 1152; attn_unit<1>(F.lds, A, v >> 3, v & 7, 0, F.lane, F.wave); }
    }
}
}

#define XB_TMO      128
#define XB_XCNT(j)  (256  + 64 * (j))
#define XB_XSUB(j)  (1280 + 64 * (j))
#define XB_XGEN(j)  (2304 + 64 * (j))
#define XB_TOP      3328
#define XB_TOPGEN   3392
#define XCD_BAR_WORDS 3456
#define XB_SPIN_CAP (1u << 18)

__device__ __forceinline__ unsigned xb_ld(unsigned* p)              { return __hip_atomic_load(p, __ATOMIC_RELAXED, __HIP_MEMORY_SCOPE_AGENT); }
__device__ __forceinline__ unsigned xb_add(unsigned* p, unsigned v) { return __hip_atomic_fetch_add(p, v, __ATOMIC_RELAXED, __HIP_MEMORY_SCOPE_AGENT); }
__device__ __forceinline__ unsigned xb_xcc_id() { return (unsigned)__builtin_amdgcn_s_getreg((3 << 11) | 20) & 0xFu; }
#define XB_SPIN(cond, bar) do { unsigned _sp = 0; while (cond) { __builtin_amdgcn_s_sleep(1); \
    if ((++_sp & 255u) == 0u) { if (xb_ld(&(bar)[XB_TMO])) break; if (_sp > XB_SPIN_CAP) { atomicAdd(&(bar)[XB_TMO], 1u); break; } } } } while (0)

struct XcdBarrier {
    unsigned* bar; unsigned x;
    volatile LAS unsigned* st;
};

__device__ __forceinline__ XcdBarrier xcd_barrier_post(unsigned* bar, volatile LAS unsigned* st) {
    XcdBarrier b; b.bar = bar; b.x = xb_xcc_id(); b.st = st;
    if (threadIdx.x == 0) (void)xb_add(&bar[XB_XCNT(b.x)], 1u);
    return b;
}
__device__ __forceinline__ void xcd_barrier_complete(unsigned* bar, unsigned x, unsigned& nloc, unsigned& nx) {
    const unsigned G = gridDim.x * gridDim.y * gridDim.z;
    unsigned sum, cnt, mine, sp = 0u;
    for (;;) {
        sum = 0u; cnt = 0u; mine = 0u;
#pragma unroll
        for (unsigned j = 0; j < 16; ++j) { const unsigned c = xb_ld(&bar[XB_XCNT(j)]); sum += c; cnt += (c > 0u) ? 1u : 0u; mine = (j == x) ? c : mine; }
        if (sum == G) break;
        __builtin_amdgcn_s_sleep(1);
        if ((++sp & 255u) == 0u) { if (xb_ld(&bar[XB_TMO])) break; if (sp > XB_SPIN_CAP) { atomicAdd(&bar[XB_TMO], 1u); break; } }
    }
    nloc = mine > 0u ? mine : 1u; nx = cnt > 0u ? cnt : 1u;
}

__device__ __forceinline__ void xcd_barrier(const XcdBarrier& b) {
    asm volatile("s_waitcnt vmcnt(0)" ::: "memory");
    __syncthreads();
    if (threadIdx.x == 0) {
        unsigned* bar = b.bar;
        __builtin_amdgcn_s_waitcnt(0);
        unsigned nloc = b.st[0], nx = b.st[1];
        if (nloc == 0u) { xcd_barrier_complete(bar, b.x, nloc, nx); b.st[0] = nloc; b.st[1] = nx; }
        const unsigned old = xb_add(&bar[XB_XSUB(b.x)], 1u);
        const unsigned gen = old / nloc;
        if (old + 1u == (gen + 1u) * nloc) {
            __builtin_amdgcn_fence(__ATOMIC_RELEASE, "agent");
            asm volatile("s_waitcnt vmcnt(0)" ::: "memory");
            const unsigned og = xb_add(&bar[XB_TOP], 1u);
            const unsigned tg = og / nx;
            if (og + 1u == (tg + 1u) * nx) xb_add(&bar[XB_TOPGEN], 1u);
            else XB_SPIN(xb_ld(&bar[XB_TOPGEN]) == tg, bar);
            __builtin_amdgcn_fence(__ATOMIC_ACQUIRE, "agent");
            xb_add(&bar[XB_XGEN(b.x)], 1u);
            asm volatile("s_waitcnt vmcnt(0)" ::: "memory");
        } else {
            XB_SPIN(xb_ld(&bar[XB_XGEN(b.x)]) == gen, bar);
            __builtin_amdgcn_fence(__ATOMIC_ACQUIRE, "agent");
            asm volatile("s_waitcnt vmcnt(0)" ::: "memory");
        }
    }
    __syncthreads();
}

struct Args { const float* in[26]; float* out; unsigned char* ws; int ph_lo, ph_hi; };
constexpr int N_PHASES = 12;

__global__ void __launch_bounds__(NWAVES * 64, 2) fwd_kernel(Args args) {
    extern __shared__ __attribute__((aligned(16))) unsigned char lds_raw[];
    Ctx F;
    F.lds = (LAS unsigned char*)lds_raw;
    F.tid = threadIdx.x; F.lane = F.tid & 63; F.wave = __builtin_amdgcn_readfirstlane(F.tid >> 6);
    F.G = gridDim.x; { const int bx = blockIdx.x; F.vcu = (F.G % 8 == 0) ? (bx % 8) * (F.G / 8) + bx / 8 : bx; }
#define ws (args.ws)
#define x_prompt (args.in[0])
#define x_sample (args.in[1])
#define Y (args.out + OUT_Y)
#define MOD ((float*)(ws + WS_MOD))
#define ROPE ((float2*)(ws + WS_ROPE))
#define GS ((float*)(ws + WS_GS))
#define B2IN ((float*)(ws + WS_B2IN))
#define B2GU ((float*)(ws + WS_B2GU))
#define SS ((float*)(ws + WS_SS))
#define WGU1 ((bf16_t*)(ws + WS_WGU1))
#define WD1 ((bf16_t*)(ws + WS_WD1))
#define WIN ((bf16_t*)(ws + WS_WIN))
#define WB ((bf16_t*)(ws + WS_WB))
#define WOUT ((bf16_t*)(ws + WS_WOUT))
#define WGU2 ((bf16_t*)(ws + WS_WGU2))
#define WD2 ((bf16_t*)(ws + WS_WD2))
#define H ((bf16_t*)(ws + WS_H))
#define H2 ((bf16_t*)(ws + WS_H2))
#define ACT ((bf16_t*)(ws + WS_ACT))
#define QAB ((bf16_t*)(ws + WS_QAB))
#define KA ((bf16_t*)(ws + WS_KA))
#define VA ((bf16_t*)(ws + WS_VA))
#define KB ((bf16_t*)(ws + WS_KB))
#define VB ((bf16_t*)(ws + WS_VB))
#define SGNA ((bf16_t*)(ws + WS_SGNA))
#define SGSWA ((bf16_t*)(ws + WS_SGSWA))
#define TMP ((bf16_t*)(ws + WS_TMP))
#define CKNA ((bf16_t*)(ws + WS_CKNA))
#define CVNA ((bf16_t*)(ws + WS_CVNA))
#define CKSWA ((bf16_t*)(ws + WS_CKSWA))
#define CVSWA ((bf16_t*)(ws + WS_CVSWA))
    const int gw = F.vcu * NWAVES + F.wave, NGW = F.G * NWAVES;
    const int lo = args.ph_lo, hi = args.ph_hi;
#define TS(i) do { if (TIMING_PHASE >= 0 && blockIdx.x == 0 && F.tid == 0) { if ((i) == TIMING_PHASE) *(volatile LAS unsigned long long*)(F.lds + MISC_OFF + 64) = __builtin_amdgcn_s_memrealtime(); \
        if ((i) == TIMING_PHASE + 1) *(volatile LAS unsigned long long*)(F.lds + MISC_OFF + 72) = __builtin_amdgcn_s_memrealtime(); } } while (0)
#define IN(k) (lo <= (k) && (k) < hi)
#define REPS(k) for (int rep_ = 0; rep_ < ((PROBE_REP == (k)) ? 2 : 1); ++rep_, (PROBE_REP == (k) && rep_ == 1) ? xcd_barrier(bar) : (void)0)
#if MK_N_LAUNCHES == 1
    for (int u = F.tid; u < (LDS_BYTES - LDSCTL_OFF) / 4; u += NWAVES * 64) ((LAS unsigned*)(F.lds + LDSCTL_OFF))[u] = 0u;
    __syncthreads();
    XcdBarrier bar = xcd_barrier_post((unsigned*)(ws + WS_CTL) + CW_BAR, (volatile LAS unsigned*)(F.lds + MISC_OFF) + 8);
#define SEAM(k) do { if (IN(k) && IN((k) + 1)) { if ((k) == 0) cg::this_grid().sync(); else xcd_barrier(bar); } } while (0)
#else
    XcdBarrier bar; bar.bar = nullptr; bar.x = 0; bar.st = nullptr;
#define SEAM(k) do { } while (0)
#endif

    TS(0);
    if (IN(0)) REPS(0) {
        if (blockIdx.x < 72) {
            LAS float* S = (LAS float*)F.lds; LAS float* RED = (LAS float*)(F.lds + 49152);
            const float* c_lat = args.in[6]; const float* c_ctx = args.in[7]; const float* w_ada = args.in[8]; const float* b_ada = args.in[9];
            for (int idx = F.tid; idx < NCOND * D; idx += NWAVES * 64) { const int i = idx >> 10, k = idx & 1023; const float c = (i == 0) ? c_ctx[k] : c_lat[(i - 1) * D + k]; S[k * 12 + i] = c / (1.0f + __expf(-c)); }
            __syncthreads();
            for (int it = blockIdx.x; it < 72; it += F.G) {
                const int n0 = it * 128, k0 = F.wave * 128;
                float a[NCOND][2];
#pragma unroll
                for (int i = 0; i < NCOND; ++i) { a[i][0] = 0.f; a[i][1] = 0.f; }
#pragma unroll 8
                for (int kk = 0; kk < 128; ++kk) { const int k = k0 + kk; const float2 w = *(const float2*)(w_ada + (size_t)k * MODW + n0 + 2 * F.lane);
#pragma unroll
                    for (int i = 0; i < NCOND; ++i) { const float s = S[k * 12 + i]; a[i][0] += s * w.x; a[i][1] += s * w.y; } }
#pragma unroll
                for (int i = 0; i < NCOND; ++i) { RED[(F.wave * NCOND + i) * 128 + 2 * F.lane] = a[i][0]; RED[(F.wave * NCOND + i) * 128 + 2 * F.lane + 1] = a[i][1]; }
                __syncthreads();
                for (int idx = F.tid; idx < NCOND * 128; idx += NWAVES * 64) { const int i = idx >> 7, c = idx & 127; float s = b_ada[n0 + c];
#pragma unroll
                    for (int w = 0; w < NWAVES; ++w) s += RED[(w * NCOND + i) * 128 + c];
                    MOD[(size_t)i * MODW + n0 + c] = s; }
                __syncthreads();
            }
        }
        if (blockIdx.x == F.G - 1) {
            for (int idx = F.tid; idx < 64 * 16; idx += NWAVES * 64) { const int pos = idx >> 4, i = idx & 15; const float fr_ = powf(10000.0f, -(float)i / 16.0f); const float ang = (float)pos * fr_; ROPE[idx] = make_float2(cosf(ang), sinf(ang)); }
        }
        {
            LAS unsigned char* scr = F.lds + F.wave * 16384;
            const int gwr = ((int)blockIdx.x >= 72 ? (int)blockIdx.x - 72 : (int)blockIdx.x + (F.G - 72)) * NWAVES + F.wave;
            for (int it = gwr; it < I_ALL; it += NGW) {
                int r = it;
                if (r < I_GU) { tr_gu(args.in[11], WGU1, 0, scr, r, F.lane); continue; } r -= I_GU;
                if (r < I_GU) { tr_gu(args.in[12], WGU1, 1, scr, r, F.lane); continue; } r -= I_GU;
                if (r < I_DN) { tr_plain(args.in[13], FF, D, WD1, FF, 0, scr, r, F.lane); continue; } r -= I_DN;
                if (r < I_IN) { tr_plain(args.in[15], D, NIN, WIN, D, 0, scr, r, F.lane); continue; } r -= I_IN;
                if (r < I_BR) { tr_plain(args.in[18], 512, D, WB, D, 0, scr, r, F.lane); continue; } r -= I_BR;
                if (r < I_BR) { tr_plain(args.in[19], 512, D, WB, D, 512, scr, r, F.lane); continue; } r -= I_BR;
                if (r < I_OUT) { tr_plain(args.in[20], D, D, WOUT, D, 0, scr, r, F.lane); continue; } r -= I_OUT;
                if (r < I_GU) { tr_gu(args.in[22], WGU2, 0, scr, r, F.lane); continue; } r -= I_GU;
                if (r < I_GU) { tr_gu(args.in[23], WGU2, 1, scr, r, F.lane); continue; } r -= I_GU;
                tr_plain(args.in[24], FF, D, WD2, FF, 0, scr, r, F.lane);
            }
        }
        {
            const int gt = (F.vcu * NWAVES * 64) + F.tid, NT = F.G * NWAVES * 64;
            constexpr int N4A = 8 * 256 * 512 / 4, N4B = 8 * 256 * 128 / 4;
            for (int i = gt; i < 2 * N4A + 2 * N4B; i += NT) {
                int r = i; const float* src; bf16_t* dst;
                if (r < N4A) { src = args.in[2]; dst = CKNA; } else if ((r -= N4A) < N4A) { src = args.in[3]; dst = CVNA; } else if ((r -= N4A) < N4B) { src = args.in[4]; dst = CKSWA; } else { r -= N4B; src = args.in[5]; dst = CVSWA; }
                const f32x4 v = ((const f32x4*)src)[r]; u32x2 w; w.x = pk2(v.x, v.y); w.y = pk2(v.z, v.w); ((u32x2*)dst)[r] = w;
            }
        }
    }
    SEAM(0); TS(1);
    if (IN(1)) REPS(1) {
        norm_rows<false>(x_prompt, x_sample, H, args.in[10], MOD, 1, 0, gw, NGW, F.lane);
        { const int gt = (F.vcu * NWAVES * 64) + F.tid, NT = F.G * NWAVES * 64;
          for (int i = gt; i < 2 * NCOND * D; i += NT) { const int st = i / (NCOND * D), r = i - st * NCOND * D, c = r >> 10, k = r & 1023;
              GS[i] = (st == 0 ? args.in[14][k] : args.in[21][k]) * (1.0f + MOD[(size_t)c * MODW + (st == 0 ? 4 : 7) * D + k]); } }
        for (int it = gw; it < (NIN + 2 * FF) / 16; it += NGW) {
            const bool in_ = it < NIN / 16; const int n0 = 16 * (in_ ? it : it - NIN / 16), nl = F.lane & 15, kq = F.lane >> 4;
            const bf16_t* wp = (in_ ? WIN : WGU2) + (size_t)(n0 + nl) * D + 8 * kq;
            const float* shp = MOD + (size_t)min(nl, NCOND - 1) * MODW + (in_ ? 3 : 6) * D + 8 * kq;
            f32x4 acc4 = (f32x4){0.f, 0.f, 0.f, 0.f};
#pragma unroll 8
            for (int s = 0; s < 32; ++s) {
                const pg8::bf16x8 bfr = *(const pg8::bf16x8*)(wp + 32 * s);
                f32x4 a0 = *(const f32x4*)(shp + 32 * s), a1 = *(const f32x4*)(shp + 32 * s + 4);
                if (nl >= NCOND) { a0 = (f32x4){0.f, 0.f, 0.f, 0.f}; a1 = a0; }
                u32x4 aw; aw.x = cvt_pk_bf16(a0.x, a0.y); aw.y = cvt_pk_bf16(a0.z, a0.w); aw.z = cvt_pk_bf16(a1.x, a1.y); aw.w = cvt_pk_bf16(a1.z, a1.w);
                acc4 = __builtin_amdgcn_mfma_f32_16x16x32_bf16(__builtin_bit_cast(pg8::bf16x8, aw), bfr, acc4, 0, 0, 0);
            }
            float* dst = in_ ? B2IN : B2GU; const int ldn = in_ ? NIN : 2 * FF;
#pragma unroll
            for (int r = 0; r < 4; ++r) { const int c = 4 * kq + r; if (c < NCOND) dst[(size_t)c * ldn + n0 + nl] = acc4[r]; }
        }
    }
    SEAM(1); TS(2);
    if (IN(2)) REPS(2) {
        pg8::Gemm g{H, WGU1, D, D, M, 2 * FF, D}; pg8::StaticOrder S; S.init(M, 2 * FF, F.G, (int)blockIdx.x);
        EpiSwiGLU<false> E{ws};
        pg8::gemm_phase<EpiSwiGLU<false>, pg8::StaticOrder, true, true>(F.lds, g, S, E);
    }
    SEAM(2); TS(3);
    if (IN(3)) REPS(3) {
        pg8::Gemm g{ACT, WD1, FF, FF, M, D, FF}; pg8::StaticOrder S; S.init(M, D, F.G, (int)blockIdx.x);
        EpiResid<0> E{x_prompt, x_sample, Y, ws};
        pg8::gemm_phase<EpiResid<0>, pg8::StaticOrder, true, true>(F.lds, g, S, E);
    }
    SEAM(3); TS(4);
    if (IN(4)) {
        pg8::Gemm g{H2, WIN, D, D, M, NIN, D}; pg8::StaticOrder S; S.init(M, NIN, F.G, (int)blockIdx.x);
        LAS unsigned char* ropel = F.lds + LDSCTL_OFF + 1024;
        for (int i = F.tid; i < 64 * 16 / 2; i += NWAVES * 64) ((LAS f32x4*)ropel)[i] = ((const f32x4*)ROPE)[i];
        __syncthreads();
        EpiIn E{ws, args.out, ropel};
        pg8::gemm_phase<EpiIn, pg8::StaticOrder, true, true>(F.lds, g, S, E);
    }
    SEAM(4); TS(5);
    if (IN(5)) {
        AttnBufs A{QAB, QAB, KA, VA, KB, VB, CKNA, CVNA, CKSWA, CVSWA, args.in[16], args.in[17]};
#if ATTN_DEBUG
        { const int gt = (F.vcu * NWAVES * 64) + F.tid, NT_ = F.G * NWAVES * 64;
          for (size_t i = gt; i < (size_t)M * 1024 / 8; i += NT_) ((u32x4*)H)[i] = ((const u32x4*)QAB)[i]; }
        cg::this_grid().sync();
        att::attn_phase(F, A);
        { AttnBufs A2{H, H, KA, VA, KB, VB, CKNA, CVNA, CKSWA, CVSWA, args.in[16], args.in[17]}; attn_naive_phase(F, A2); }
        cg::this_grid().sync();
        { float sd[4] = {0.f, 0.f, 0.f, 0.f}, sr[4] = {0.f, 0.f, 0.f, 0.f};
          const int gt = (F.vcu * NWAVES * 64) + F.tid, NT_ = F.G * NWAVES * 64;
          for (size_t i = gt; i < (size_t)M * 1024 / 8; i += NT_) {
              const int row = (int)(i >> 7), col = (int)(i & 127) * 8; const int ty = (row >= M_CTX ? 2 : 0) + (col >= 512 ? 1 : 0);
              const u32x4 a = ((const u32x4*)QAB)[i], b = ((const u32x4*)H)[i]; float d2 = 0.f, r2 = 0.f;
#pragma unroll
              for (int e = 0; e < 4; ++e) { const float a0 = __uint_as_float(a[e] << 16), a1 = __uint_as_float(a[e] & 0xffff0000u), b0 = __uint_as_float(b[e] << 16), b1 = __uint_as_float(b[e] & 0xffff0000u);
                  d2 += (a0 - b0) * (a0 - b0) + (a1 - b1) * (a1 - b1); r2 += b0 * b0 + b1 * b1; }
#pragma unroll
              for (int k = 0; k < 4; ++k) { sd[k] += (ty == k) ? d2 : 0.f; sr[k] += (ty == k) ? r2 : 0.f; } }
#pragma unroll
          for (int k = 0; k < 4; ++k) { const float d = wave_sum(sd[k]), r = wave_sum(sr[k]); if (F.lane == 0) { atomicAdd((float*)(ws + WS_CTL) + 64 * (2 * k), d); atomicAdd((float*)(ws + WS_CTL) + 64 * (2 * k + 1), r); } } }
#else
        if (PROBE_REP == 5) { AttnBufs A2{H2, QAB, KA, VA, KB, VB, CKNA, CVNA, CKSWA, CVSWA, args.in[16], args.in[17]}; att::attn_phase(F, A2); xcd_barrier(bar); }
        att::attn_phase(F, A);
#endif
    }
    SEAM(5); TS(6);
    if (IN(6)) REPS(6) {
        pg8::Gemm g{QAB, WB, D, D, M, D, 512}; pg8::StaticOrder S; S.init(M, D, F.G, (int)blockIdx.x);
        EpiMerge<false> E{ws};
        pg8::gemm_phase<EpiMerge<false>, pg8::StaticOrder, true, true>(F.lds, g, S, E);
    }
    SEAM(6); TS(7);
    if (IN(7)) REPS(7) {
        pg8::Gemm g{QAB + 512, WB + 512, D, D, M, D, 512}; pg8::StaticOrder S; S.init(M, D, F.G, (int)blockIdx.x);
        EpiMerge<true> E{ws};
        pg8::gemm_phase<EpiMerge<true>, pg8::StaticOrder, true, true>(F.lds, g, S, E);
    }
    SEAM(7); TS(8);
    if (IN(8)) {
        pg8::Gemm g{H, WOUT, D, D, M, D, D}; pg8::StaticOrder S; S.init(M, D, F.G, (int)blockIdx.x);
        EpiResid<1> E{nullptr, nullptr, Y, ws};
        pg8::gemm_phase<EpiResid<1>, pg8::StaticOrder, true, true>(F.lds, g, S, E);
    }
    SEAM(8); TS(9);
    if (IN(9)) REPS(9) {
        pg8::Gemm g{H2, WGU2, D, D, M, 2 * FF, D}; pg8::StaticOrder S; S.init(M, 2 * FF, F.G, (int)blockIdx.x);
        EpiSwiGLU<true> E{ws};
        pg8::gemm_phase<EpiSwiGLU<true>, pg8::StaticOrder, true, true>(F.lds, g, S, E);
    }
    SEAM(9); TS(10);
    if (IN(10)) {
        pg8::Gemm g{ACT, WD2, FF, FF, M, D, FF}; pg8::StaticOrder S; S.init(M, D, F.G, (int)blockIdx.x);
        EpiResid<2> E{nullptr, nullptr, Y, ws};
        pg8::gemm_phase<EpiResid<2>, pg8::StaticOrder, true, true>(F.lds, g, S, E);
    }
    SEAM(10); TS(11);
    if (IN(11)) {
        norm_rows<true>(Y, Y + (size_t)M_CTX * D, Y, args.in[25], nullptr, 0, 0, gw, NGW, F.lane);
#if ATTN_DEBUG
        { const float* cw = (const float*)(ws + WS_CTL); bool bad[4];
#pragma unroll
          for (int k = 0; k < 4; ++k) bad[k] = !(cw[64 * (2 * k)] <= ATTN_DEBUG_TOL * cw[64 * (2 * k + 1)]);
          asm volatile("s_waitcnt vmcnt(0)" ::: "memory"); __syncthreads();
          if (blockIdx.x == 0 && F.tid == 0) { const float qn = __builtin_nanf("");
              if (bad[0]) args.out[OUT_NAK] = qn;
              if (bad[1]) args.out[OUT_NAV] = qn;
              if (bad[2]) args.out[OUT_SWK] = qn;
              if (bad[3]) args.out[OUT_SWV] = qn; } }
#endif
    }
    if (TIMING_PHASE >= 0) { xcd_barrier(bar); TS(12);
        if (blockIdx.x == 0 && F.tid == 0) { const unsigned long long ts_a = *(volatile LAS unsigned long long*)(F.lds + MISC_OFF + 64), ts_b = *(volatile LAS unsigned long long*)(F.lds + MISC_OFF + 72); const unsigned long long t_end = __builtin_amdgcn_s_memrealtime() + (unsigned long long)TIMING_ALPHA * (ts_b - ts_a);
            while (__builtin_amdgcn_s_memrealtime() < t_end) __builtin_amdgcn_s_sleep(16); } }
#undef TS
#undef IN
#undef SEAM
#undef REPS
#undef ws
#undef x_prompt
#undef x_sample
#undef Y
#undef MOD
#undef ROPE
#undef GS
#undef B2IN
#undef B2GU
#undef SS
#undef WGU1
#undef WD1
#undef WIN
#undef WB
#undef WOUT
#undef WGU2
#undef WD2
#undef H
#undef H2
#undef ACT
#undef QAB
#undef KA
#undef VA
#undef KB
#undef VB
#undef SGNA
#undef SGSWA
#undef TMP
#undef CKNA
#undef CVNA
#undef CKSWA
#undef CVSWA
}

extern "C" void kernel_launch(void* const* d_in, const int* in_sizes, int n_in, void* d_out, int out_size, void* d_ws, size_t ws_size, hipStream_t stream) {
    static int grid = 0;
    if (grid == 0) {
        if (n_in != 26 || out_size != (int)OUT_END || ws_size < WS_END) { fprintf(stderr, "kernel_launch: unexpected shapes (n_in %d out %d ws %zu); nothing launched\n", n_in, out_size, ws_size); grid = -1; return; }
        int dev = 0, cus = 0, per_cu = 0;
        if (hipGetDevice(&dev) != hipSuccess || hipDeviceGetAttribute(&cus, hipDeviceAttributeMultiprocessorCount, dev) != hipSuccess) { grid = -1; return; }
        if (hipFuncSetAttribute((const void*)fwd_kernel, hipFuncAttributeMaxDynamicSharedMemorySize, LDS_BYTES) != hipSuccess) { fprintf(stderr, "kernel_launch: hipFuncSetAttribute failed\n"); grid = -1; return; }
        if (hipOccupancyMaxActiveBlocksPerMultiprocessor(&per_cu, (const void*)fwd_kernel, NWAVES * 64, LDS_BYTES) != hipSuccess || per_cu < 1) { fprintf(stderr, "kernel_launch: occupancy query says %d\n", per_cu); per_cu = 1; }
        (void)hipGetLastError();
        grid = cus;
    }
    if (grid < 0) return;
    if (hipMemsetAsync((char*)d_ws + WS_CTL, 0, CTL_ZERO_BYTES, stream) != hipSuccess) { fprintf(stderr, "kernel_launch: memset failed\n"); return; }
    Args a{};
    for (int i = 0; i < 26; ++i) a.in[i] = (const float*)d_in[i];
    a.out = (float*)d_out; a.ws = (unsigned char*)d_ws;
#if MK_N_LAUNCHES == 1
    a.ph_lo = 0; a.ph_hi = N_PHASES;
    void* kargs[] = {&a};
    hipError_t e = hipLaunchCooperativeKernel((const void*)fwd_kernel, dim3(grid), dim3(NWAVES * 64), kargs, LDS_BYTES, stream);
    if (e != hipSuccess) fprintf(stderr, "cooperative launch failed: %s (grid %d)\n", hipGetErrorString(e), grid);
#else
    for (int p = 0; p < N_PHASES; ++p) { a.ph_lo = p; a.ph_hi = p + 1; hipLaunchKernelGGL(fwd_kernel, dim3(grid), dim3(NWAVES * 64), LDS_BYTES, stream, a); }
#endif
}
```

```cpp
#include <hip/hip_runtime.h>
#include <hip/hip_cooperative_groups.h>
#include <cstdio>
#include <cstdint>
namespace cg = cooperative_groups;

#ifndef ATTN_DEBUG
#define ATTN_DEBUG 0
#endif
#define ATTN_DEBUG_TOL 2e-5f
#ifndef POISON_DEBUG
#define POISON_DEBUG 0
#endif
#ifndef TIMING_PHASE
#define TIMING_PHASE -1
#endif
#define TIMING_ALPHA 8
#ifndef PROBE_REP
#define PROBE_REP -1
#endif
#ifndef MK_N_LAUNCHES
#define MK_N_LAUNCHES 1
#endif

namespace pg8 {
#define PG8_LAS __attribute__((address_space(3)))
typedef unsigned short bf16_t;
typedef short bf16x8 __attribute__((ext_vector_type(8)));
typedef float f32x4 __attribute__((ext_vector_type(4)));
typedef unsigned u32x4 __attribute__((ext_vector_type(4)));
typedef unsigned u32x2 __attribute__((ext_vector_type(2)));
constexpr int BM = 256, BK = 64, HALF = 128, HTB = HALF * BK * 2  , STAGE_BYTES = 8 * HTB, NXCD = 8, WGM = 8;

__host__ __device__ __forceinline__ int lds_byte(int r, int c) { const int st = (r >> 4) * 2 + (c >> 5), rr = r & 15, cc = c & 31, ob = rr * 64 + cc * 2; return st * 1024 + (ob ^ (((ob >> 9) & 1) << 5)); }
__host__ __device__ __forceinline__ void stage_rc(int b, int& R, int& C) { const int st = b / 1024, sb = b % 1024, swz = sb ^ (((sb >> 9) & 1) << 5); R = (st >> 1) * 16 + swz / 64; C = (st & 1) * 32 + (swz % 64) / 2; }
__host__ __device__ __forceinline__ int perm32(int rho) { const int n = rho >> 4, i = rho & 15; return 8 * (i >> 2) + 4 * n + (i & 3); }

struct Unit { int pm, pn; };
struct Gemm { const bf16_t* A; const bf16_t* Bt; int lda, ldb, M, N, K; };

struct StaticOrder {
    int nM, nN, nwg, G, c;
    __host__ __device__ void init(int M, int N, int G_, int c_) { nM = M / BM; nN = N / BM; nwg = nM * nN; G = G_; c = c_; }
    __host__ __device__ bool next(int i, Unit& u) const {
        const long L = (long)i * G + c; if (L >= nwg) return false;
        int wgid = (int)L; { const int q = nwg / NXCD, r = nwg % NXCD, xcd = wgid % NXCD, off = wgid / NXCD; wgid = (xcd < r ? xcd * (q + 1) : r * (q + 1) + (xcd - r) * q) + off; }
        const int nig = WGM * nN, gid = wgid / nig, fm = gid * WGM, gsz = (nM - fm) < WGM ? (nM - fm) : WGM;
        u.pm = fm + ((wgid % nig) % gsz); u.pn = (wgid % nig) / gsz; return true;
    }
    __device__ __forceinline__ void a_ready(const Unit&) const {}
    __device__ __forceinline__ void done(const Unit&) const {}
};
typedef float f32x2_cv __attribute__((ext_vector_type(2))); typedef __bf16 bf16x2_cv __attribute__((ext_vector_type(2)));
__device__ __forceinline__ unsigned cvt_pk_bf16(float lo, float hi) { f32x2_cv v = {lo, hi}; bf16x2_cv b = __builtin_convertvector(v, bf16x2_cv); return __builtin_bit_cast(unsigned, b); }

template <class Epi, class Sched, bool ALIGN_EPI = false, bool SP2 = false>
__device__ __forceinline__ void gemm_phase(PG8_LAS unsigned char* lds, const Gemm g, const Sched& S, const Epi& E) {
    const int tid = threadIdx.x, wid = __builtin_amdgcn_readfirstlane(tid >> 6), lane = tid & 63, wr = wid >> 2, wc = wid & 3, fr = lane & 15, fq = lane >> 4;
    const int K = g.K, nt = K / BK;
    unsigned voffA[2], voffB[2];
#pragma unroll
    for (int i = 0; i < 2; ++i) { int R, C; stage_rc(tid * 16 + i * 8192, R, C); const int Rb = Epi::PERM ? ((R & ~31) + perm32(R & 31)) : R;
        voffA[i] = (unsigned)(R * g.lda + C) * 2u; voffB[i] = (unsigned)(Rb * g.ldb + C) * 2u; }
    const size_t kstep = (size_t)(BK * 2);
    const size_t hstepA = (size_t)HALF * g.lda * 2, hstepB = (size_t)HALF * g.ldb * 2;
    const size_t tstepA = 2 * hstepA, tstepB = 2 * hstepB;
    const unsigned ldsw = (unsigned)wid * 1024u;
    const int aoff = lds_byte(wr * 64 + fr, fq * 8), boff = lds_byte(wc * 32 + fr, fq * 8);
#define PG8_SA(b, h) (((b) * 2 + (h)) * HTB)
#define PG8_SB(b, h) ((4 + (b) * 2 + (h)) * HTB)
#define PG8_STAGE(bufoff, gbase, voff) do { _Pragma("unroll") for (int _i = 0; _i < 2; ++_i) \
        __builtin_amdgcn_global_load_lds((const unsigned*)((const char*)(gbase) + (voff)[_i]), (PG8_LAS unsigned*)(lds + (bufoff) + ldsw + _i * 8192), 16, 0, 0); } while (0)
#define PG8_LDA(dst, b, h) do { _Pragma("unroll") for (int m = 0; m < 4; ++m) _Pragma("unroll") for (int k = 0; k < 2; ++k) dst[m][k] = *(const PG8_LAS bf16x8*)(lds + PG8_SA(b, h) + aoff + m * 2048 + k * 1024); } while (0)
#define PG8_LDB(dst, b, h) do { _Pragma("unroll") for (int n = 0; n < 2; ++n) _Pragma("unroll") for (int k = 0; k < 2; ++k) dst[n][k] = *(const PG8_LAS bf16x8*)(lds + PG8_SB(b, h) + boff + n * 2048 + k * 1024); } while (0)
#define PG8_MMA(ai, bj, At, Bt) do { __builtin_amdgcn_s_setprio(1); _Pragma("unroll") for (int m = 0; m < 4; ++m) _Pragma("unroll") for (int n = 0; n < 2; ++n) _Pragma("unroll") for (int k = 0; k < 2; ++k) \
        acc[ai][bj][m][n] = __builtin_amdgcn_mfma_f32_16x16x32_bf16(Bt[n][k], At[m][k], acc[ai][bj][m][n], 0, 0, 0); __builtin_amdgcn_s_setprio(0); } while (0)
#define PG8_WAIT_V(n) asm volatile("s_waitcnt vmcnt(" #n ")" ::: "memory")
#define PG8_WAIT_L(n) asm volatile("s_waitcnt lgkmcnt(" #n ")" ::: "memory")
#define PG8_BAR __builtin_amdgcn_s_barrier()
#define PG8_SCHED __builtin_amdgcn_sched_barrier(0)
    Unit cur, nxt; int ui = 0;
    if (!S.next(0, cur)) return;
    f32x4 acc[2][2][4][2];
#pragma unroll
    for (int a = 0; a < 2; ++a)
#pragma unroll
        for (int b = 0; b < 2; ++b)
#pragma unroll
            for (int m = 0; m < 4; ++m)
#pragma unroll
                for (int n = 0; n < 2; ++n) acc[a][b][m][n] = (f32x4){0.f, 0.f, 0.f, 0.f};
    bf16x8 At[4][2], B0[2][2], B1[2][2];
    const char* cA = (const char*)g.A + (size_t)cur.pm * tstepA; const char* cB = (const char*)g.Bt + (size_t)cur.pn * tstepB;
    S.a_ready(cur);
    if constexpr (SP2) {
        PG8_STAGE(PG8_SB(0, 0), cB, voffB); PG8_STAGE(PG8_SB(0, 1), cB + hstepB, voffB); PG8_STAGE(PG8_SA(0, 0), cA, voffA); PG8_STAGE(PG8_SA(0, 1), cA + hstepA, voffA);
        if (wr == 1) PG8_BAR;
        PG8_WAIT_V(2); PG8_BAR;
        PG8_STAGE(PG8_SB(1, 0), cB + kstep, voffB); PG8_STAGE(PG8_SA(1, 0), cA + kstep, voffA); PG8_STAGE(PG8_SB(1, 1), cB + hstepB + kstep, voffB);
        PG8_WAIT_V(6); PG8_BAR;
    } else {
        PG8_STAGE(PG8_SB(0, 0), cB, voffB); PG8_STAGE(PG8_SA(0, 0), cA, voffA); PG8_STAGE(PG8_SB(0, 1), cB + hstepB, voffB); PG8_STAGE(PG8_SA(0, 1), cA + hstepA, voffA);
        if (wr == 1) PG8_BAR;
        PG8_WAIT_V(4); PG8_BAR;
        PG8_STAGE(PG8_SB(1, 0), cB + kstep, voffB); PG8_STAGE(PG8_SA(1, 0), cA + kstep, voffA); PG8_STAGE(PG8_SB(1, 1), cB + hstepB + kstep, voffB);
        PG8_WAIT_V(6); PG8_BAR;
    }
    for (;;) {
        const bool has_next = S.next(ui + 1, nxt);
        const char* nA = has_next ? (const char*)g.A + (size_t)nxt.pm * tstepA : cA; const char* nB = has_next ? (const char*)g.Bt + (size_t)nxt.pn * tstepB : cB;
        for (int t = 0; t < nt; t += 2) {
            if constexpr (Epi::MID_T > 0) { if (t == Epi::MID_T) E.mid(acc, cur, wr, wc, fr, fq); }
            const bool last = (t == nt - 2);
            const char* a1 = cA + (size_t)(t + 1) * kstep;
            const char* a2 = last ? nA : cA + (size_t)(t + 2) * kstep; const char* b2 = last ? nB : cB + (size_t)(t + 2) * kstep;
            const char* a3 = a2 + kstep; const char* b3 = b2 + kstep;
            if (last && has_next) S.a_ready(nxt);
            if constexpr (SP2) {
            PG8_LDB(B0, 0, 0); PG8_LDB(B1, 0, 1); PG8_SCHED; PG8_LDA(At, 0, 0); PG8_STAGE(PG8_SA(1, 1), a1 + hstepA, voffA);
            PG8_WAIT_V(8); PG8_WAIT_L(0); PG8_BAR; PG8_MMA(0, 0, At, B0); PG8_MMA(0, 1, At, B1); PG8_BAR; PG8_SCHED;
            PG8_LDA(At, 0, 1); PG8_STAGE(PG8_SB(0, 0), b2, voffB); PG8_STAGE(PG8_SB(0, 1), b2 + hstepB, voffB); PG8_STAGE(PG8_SA(0, 0), a2, voffA);
            PG8_WAIT_V(8); PG8_WAIT_L(0); PG8_BAR; PG8_MMA(1, 0, At, B0); PG8_MMA(1, 1, At, B1); PG8_BAR; PG8_SCHED;
            PG8_LDB(B0, 1, 0); PG8_LDB(B1, 1, 1); PG8_SCHED; PG8_LDA(At, 1, 0); PG8_STAGE(PG8_SA(0, 1), a2 + hstepA, voffA);
            PG8_WAIT_V(8); PG8_WAIT_L(0); PG8_BAR; PG8_MMA(0, 0, At, B0); PG8_MMA(0, 1, At, B1); PG8_BAR; PG8_SCHED;
            PG8_LDA(At, 1, 1); PG8_STAGE(PG8_SB(1, 0), b3, voffB); PG8_STAGE(PG8_SB(1, 1), b3 + hstepB, voffB); PG8_STAGE(PG8_SA(1, 0), a3, voffA);
            PG8_WAIT_V(8); PG8_WAIT_L(0); PG8_BAR; PG8_MMA(1, 0, At, B0); PG8_MMA(1, 1, At, B1); PG8_BAR; PG8_SCHED;
            } else {
            PG8_LDB(B0, 0, 0); PG8_SCHED; PG8_LDA(At, 0, 0); PG8_STAGE(PG8_SA(1, 1), a1 + hstepA, voffA);
            PG8_WAIT_L(8); PG8_BAR; PG8_WAIT_L(0); PG8_MMA(0, 0, At, B0); PG8_BAR; PG8_SCHED;
            PG8_LDB(B1, 0, 1); PG8_STAGE(PG8_SB(0, 0), b2, voffB);
            PG8_BAR; PG8_WAIT_L(0); PG8_MMA(0, 1, At, B1); PG8_BAR;
            PG8_LDA(At, 0, 1); PG8_STAGE(PG8_SA(0, 0), a2, voffA);
            PG8_BAR; PG8_WAIT_L(0); PG8_MMA(1, 0, At, B0); PG8_BAR; PG8_SCHED;
            PG8_STAGE(PG8_SB(0, 1), b2 + hstepB, voffB);
            PG8_WAIT_V(6); PG8_BAR; PG8_MMA(1, 1, At, B1); PG8_BAR;
            PG8_LDB(B0, 1, 0); PG8_SCHED; PG8_LDA(At, 1, 0); PG8_STAGE(PG8_SA(0, 1), a2 + hstepA, voffA);
            PG8_WAIT_L(8); PG8_BAR; PG8_WAIT_L(0); PG8_MMA(0, 0, At, B0); PG8_BAR; PG8_SCHED;
            PG8_LDB(B1, 1, 1); PG8_STAGE(PG8_SB(1, 0), b3, voffB);
            PG8_BAR; PG8_WAIT_L(0); PG8_MMA(0, 1, At, B1); PG8_BAR;
            PG8_LDA(At, 1, 1); PG8_STAGE(PG8_SA(1, 0), a3, voffA);
            PG8_BAR; PG8_WAIT_L(0); PG8_MMA(1, 0, At, B0); PG8_BAR; PG8_SCHED;
            PG8_STAGE(PG8_SB(1, 1), b3 + hstepB, voffB);
            PG8_WAIT_V(6); PG8_BAR; PG8_MMA(1, 1, At, B1); PG8_BAR;
            }
        }
        if constexpr (ALIGN_EPI) { if (wr == 0) PG8_BAR; }
        if constexpr (!Epi::AFTER_DRAIN) { E(acc, cur, wr, wc, fr, fq); S.done(cur); }
        if (!has_next) break;
#pragma unroll
        for (int a = 0; a < 2; ++a)
#pragma unroll
            for (int b = 0; b < 2; ++b)
#pragma unroll
                for (int m = 0; m < 4; ++m)
#pragma unroll
                    for (int n = 0; n < 2; ++n) acc[a][b][m][n] = (f32x4){0.f, 0.f, 0.f, 0.f};
        cur = nxt; cA = nA; cB = nB; ++ui;
        if constexpr (ALIGN_EPI) { if (wr == 1) PG8_BAR; }
    }
    PG8_WAIT_V(0);
    if constexpr (!ALIGN_EPI) { if (wr == 0) PG8_BAR; }
    PG8_BAR;
    if constexpr (Epi::AFTER_DRAIN) { E.fused(acc, cur, wr, wc, fr, fq, lds, wid, lane); S.done(cur); }
#undef PG8_SA
#undef PG8_SB
#undef PG8_STAGE
#undef PG8_LDA
#undef PG8_LDB
#undef PG8_MMA
#undef PG8_WAIT_V
#undef PG8_WAIT_L
#undef PG8_BAR
#undef PG8_SCHED
}
}

using pg8::bf16_t; using pg8::f32x4; using pg8::u32x4; using pg8::u32x2; using pg8::Unit; using pg8::cvt_pk_bf16;
#define LAS __attribute__((address_space(3)))

constexpr int D = 1024, FF = 2816, NIN = 4352;
constexpr int M_CTX = 4096, M_LAT = 16384, M = M_CTX + M_LAT;
constexpr int LAT_N = 2048, CTX_L = 256, PAST = 256, GRID_W = 64;
constexpr int NCOND = 9, MODW = 9 * D;
constexpr float EPS = 1e-6f, LOG2E = 1.4426950408889634f, QSCALE = 0.125f * LOG2E;
constexpr int NWAVES = 8;

constexpr size_t OUT_Y = 0, OUT_NAK = (size_t)M * D, OUT_NAV = OUT_NAK + (size_t)M_CTX * 512, OUT_SWK = OUT_NAV + (size_t)M_CTX * 512, OUT_SWV = OUT_SWK + (size_t)M_CTX * 128, OUT_END = OUT_SWV + (size_t)M_CTX * 128;

constexpr size_t MiB = 1u << 20;
constexpr size_t WS_CTL = 0, CTL_ZERO_BYTES = 1 * MiB;
constexpr size_t WS_MOD = 1 * MiB;
constexpr size_t WS_ROPE = 1 * MiB + 512 * 1024;
constexpr size_t WS_GS = 2 * MiB;
constexpr size_t WS_B2IN = 2 * MiB + 256 * 1024;
constexpr size_t WS_B2GU = 2 * MiB + 512 * 1024;
constexpr size_t WS_SS = 3 * MiB;
constexpr size_t WS_WGU1 = 8 * MiB;
constexpr size_t WS_WD1 = 19 * MiB;
constexpr size_t WS_WIN = WS_WD1 + 5 * MiB + 512 * 1024;
constexpr size_t WS_WB = 33 * MiB;
constexpr size_t WS_WOUT = 35 * MiB;
constexpr size_t WS_WGU2 = 37 * MiB, WS_WD2 = 48 * MiB;
constexpr size_t WS_CKNA = 54 * MiB, WS_CVNA = 56 * MiB, WS_CKSWA = 58 * MiB, WS_CVSWA = 58 * MiB + 512 * 1024;
constexpr size_t WS_H = 60 * MiB;
constexpr size_t WS_H2 = 100 * MiB;
constexpr size_t WS_R = 140 * MiB;
constexpr size_t WS_ACT = WS_R;
constexpr size_t WS_QAB = WS_R, WS_KA = WS_R + 40 * MiB, WS_VA = WS_R + 60 * MiB, WS_KB = WS_R + 80 * MiB, WS_VB = WS_R + 85 * MiB;
constexpr size_t WS_SGNA = WS_R + 90 * MiB, WS_SGSWA = WS_R + 130 * MiB;
constexpr size_t WS_TMP = WS_KA;
constexpr size_t WS_END = WS_R + 170 * MiB;
static_assert(WS_WIN + (size_t)NIN * D * 2 <= WS_WB && WS_WD2 + (size_t)D * FF * 2 <= WS_CKNA && WS_SS + (size_t)2 * M * 16 * 4 <= WS_WGU1 && WS_B2GU + 9 * 5632 * 4 <= WS_SS, "ws map");

constexpr int RING_BYTES = 131072, LDSCTL_OFF = RING_BYTES, MISC_OFF = LDSCTL_OFF + 320, LDS_BYTES = 147456;
constexpr int CW_BAR = 4096;

__device__ __forceinline__ float bf2f(unsigned short u) { return __uint_as_float((unsigned)u << 16); }
__device__ __forceinline__ unsigned f2bf(float f) { unsigned u = __float_as_uint(f); return (u + 0x7fffu + ((u >> 16) & 1u)) >> 16; }
__device__ __forceinline__ unsigned pk2(float lo, float hi) { return f2bf(lo) | (f2bf(hi) << 16); }
__device__ __forceinline__ float wave_sum(float v) {
#pragma unroll
    for (int o = 1; o < 64; o <<= 1) v += __shfl_xor(v, o);
    return v;
}
__device__ __forceinline__ int cond_of_tile(int pm) { return pm < 16 ? 0 : 1 + ((pm - 16) >> 3); }
__device__ __forceinline__ int cond_of_row(int row) { return row < M_CTX ? 0 : 1 + ((row - M_CTX) >> 11); }

__device__ __forceinline__ float sigmoid_fast(float x) { return __builtin_amdgcn_rcpf(1.0f + __builtin_amdgcn_exp2f(-LOG2E * x)); }
__device__ __forceinline__ float row_rstd(const float* SS, int row) {
    const f32x4* p = (const f32x4*)(SS + (size_t)row * 16); const f32x4 a = p[0], b = p[1], c = p[2], d = p[3];
    const float s = ((a.x + a.y) + (a.z + a.w)) + ((b.x + b.y) + (b.z + b.w)) + ((c.x + c.y) + (c.z + c.w)) + ((d.x + d.y) + (d.z + d.w));
    return 1.0f / sqrtf(s * (1.0f / D) + EPS);
}
__device__ __forceinline__ u32x4 pack8(const f32x4& a, const f32x4& b) { u32x4 w; w.x = cvt_pk_bf16(a.x, a.y); w.y = cvt_pk_bf16(a.z, a.w); w.z = cvt_pk_bf16(b.x, b.y); w.w = cvt_pk_bf16(b.z, b.w); return w; }

template <bool NORM> struct EpiSwiGLU {
    static constexpr bool PERM = true, AFTER_DRAIN = false; static constexpr int MID_T = 0;
    unsigned char* wsb;
    __device__ __forceinline__ void operator()(const f32x4 (&acc)[2][2][4][2], const Unit& u, int wr, int wc, int fr, int fq) const {
        bf16_t* O = (bf16_t*)(wsb + WS_ACT); const float* SS = (const float*)(wsb + WS_SS) + (size_t)M * 16; const float* B2 = (const float*)(wsb + WS_B2GU);
        const int row0 = u.pm * 256 + wr * 64 + fr, col0 = u.pn * 128 + wc * 32 + 8 * fq;
        f32x4 bg[2], bu[2]; float rs[2][4];
        if (NORM) { const float* b2 = B2 + (size_t)cond_of_tile(u.pm) * (2 * FF) + u.pn * 256 + wc * 32 + 8 * fq;
            bg[0] = *(const f32x4*)(b2); bg[1] = *(const f32x4*)(b2 + 4); bu[0] = *(const f32x4*)(b2 + 128); bu[1] = *(const f32x4*)(b2 + 132);
#pragma unroll
            for (int ai = 0; ai < 2; ++ai)
#pragma unroll
                for (int m = 0; m < 4; ++m) rs[ai][m] = row_rstd(SS, row0 + ai * 128 + m * 16); }
#pragma unroll
        for (int ai = 0; ai < 2; ++ai)
#pragma unroll
            for (int m = 0; m < 4; ++m) {
                f32x4 o[2];
#pragma unroll
                for (int n = 0; n < 2; ++n)
#pragma unroll
                    for (int j = 0; j < 4; ++j) { float g = acc[ai][0][m][n][j], up = acc[ai][1][m][n][j]; if (NORM) { g = g * rs[ai][m] + bg[n][j]; up = up * rs[ai][m] + bu[n][j]; } o[n][j] = g * up * sigmoid_fast(g); }
                *(u32x4*)(O + ((unsigned)(row0 + ai * 128 + m * 16) * (unsigned)FF + (unsigned)col0)) = pack8(o[0], o[1]);
            }
    }
};

template <int STAGE> struct EpiResid {
    static constexpr bool PERM = true, AFTER_DRAIN = false; static constexpr int MID_T = 0;
    const float* xp; const float* xs; float* out; unsigned char* wsb;
    __device__ __forceinline__ void operator()(const f32x4 (&acc)[2][2][4][2], const Unit& u, int wr, int wc, int fr, int fq) const {
        constexpr int gate_idx = STAGE == 0 ? 2 : STAGE == 1 ? 5 : 8; constexpr float coef = STAGE == 1 ? 1.0f : 0.5f; constexpr bool NEXT = STAGE < 2;
        const float* base_ctx = STAGE == 0 ? xp : out; const float* base_lat = STAGE == 0 ? xs : out + (size_t)M_CTX * D;
        const float* mod = (const float*)(wsb + WS_MOD); bf16_t* HN = (bf16_t*)(wsb + WS_H2);
        const float* gs = (const float*)(wsb + WS_GS) + (STAGE == 1 ? NCOND * D : 0); float* SS = (float*)(wsb + WS_SS) + (STAGE == 1 ? (size_t)M * 16 : 0);
        const int row0 = u.pm * 256 + wr * 64 + fr, col0 = u.pn * 256 + wc * 32 + 8 * fq, cnd = cond_of_tile(u.pm);
        const float* gate = mod + (size_t)cnd * MODW + gate_idx * D + col0;
        f32x4 gv[2][2], sv[2][2];
#pragma unroll
        for (int bj = 0; bj < 2; ++bj)
#pragma unroll
            for (int n = 0; n < 2; ++n) { gv[bj][n] = *(const f32x4*)(gate + bj * 128 + n * 4) * coef; if (NEXT) sv[bj][n] = *(const f32x4*)(gs + (size_t)cnd * D + col0 + bj * 128 + n * 4); }
#pragma unroll
        for (int ai = 0; ai < 2; ++ai)
#pragma unroll
            for (int mh = 0; mh < 2; ++mh) {
                f32x4 pre[2][2][2];
#pragma unroll
                for (int mm = 0; mm < 2; ++mm) { const int row = row0 + ai * 128 + (2 * mh + mm) * 16;
                    const float* bp = (row < M_CTX ? base_ctx + ((unsigned)row * (unsigned)D + (unsigned)col0) : base_lat + ((unsigned)(row - M_CTX) * (unsigned)D + (unsigned)col0));
#pragma unroll
                    for (int bj = 0; bj < 2; ++bj)
#pragma unroll
                        for (int n = 0; n < 2; ++n) pre[mm][bj][n] = *(const f32x4*)(bp + bj * 128 + n * 4); }
#pragma unroll
                for (int mm = 0; mm < 2; ++mm) { const int m = 2 * mh + mm, row = row0 + ai * 128 + m * 16;
                    const unsigned eo = (unsigned)row * (unsigned)D + (unsigned)col0; float* op = out + eo; float s2 = 0.f;
#pragma unroll
                    for (int bj = 0; bj < 2; ++bj) {
                        const f32x4 v0 = pre[mm][bj][0] + gv[bj][0] * acc[ai][bj][m][0], v1 = pre[mm][bj][1] + gv[bj][1] * acc[ai][bj][m][1];
                        *(f32x4*)(op + bj * 128) = v0; *(f32x4*)(op + bj * 128 + 4) = v1;
                        if (NEXT) { s2 += ((v0.x * v0.x + v0.y * v0.y) + (v0.z * v0.z + v0.w * v0.w)) + ((v1.x * v1.x + v1.y * v1.y) + (v1.z * v1.z + v1.w * v1.w));
                                    *(u32x4*)(HN + eo + bj * 128) = pack8(v0 * sv[bj][0], v1 * sv[bj][1]); } }
                    if (NEXT) { s2 += __shfl_xor(s2, 16); s2 += __shfl_xor(s2, 32); if (fq == 0) SS[(size_t)row * 16 + u.pn * 4 + wc] = s2; } }
            }
    }
};

struct EpiIn {
    static constexpr bool PERM = true, AFTER_DRAIN = false; static constexpr int MID_T = 0;
    unsigned char* wsb; float* outp; LAS unsigned char* ropel;
    template <int MODE> __device__ __forceinline__ void half(const f32x4 (&acc)[2][2][4][2], const float (&rs)[2][4], int pn, int bj, int pm, int wr, int wc, int fr, int fq, bf16_t* dst, int ld, int dcol, float* fdst, float qs) const {
        const int row0 = pm * 256 + wr * 64 + fr, c0 = dcol + wc * 32 + 8 * fq;
        const bool lat = pm >= 16;
        const float* b2 = (const float*)(wsb + WS_B2IN) + (size_t)cond_of_tile(pm) * NIN + pn * 256 + bj * 128 + wc * 32 + 8 * fq;
        const f32x4 b2a = *(const f32x4*)b2, b2b = *(const f32x4*)(b2 + 4);
        const LAS f32x4* rope = (const LAS f32x4*)ropel;
#pragma unroll
        for (int ai = 0; ai < 2; ++ai) {
#pragma unroll
            for (int m = 0; m < 4; ++m) {
                const int row = row0 + ai * 128 + m * 16;
                f32x4 v0 = acc[ai][bj][m][0] * rs[ai][m] + b2a, v1 = acc[ai][bj][m][1] * rs[ai][m] + b2b;
                const unsigned eoff = (unsigned)row * (unsigned)ld + (unsigned)c0;
                if (fdst && !lat) { *(f32x4*)(fdst + eoff) = v0; *(f32x4*)(fdst + eoff + 4) = v1; }
                if (MODE == 1 && lat) {
                    const float sgn = (fq & 2) ? 1.0f : -1.0f;
                    const int t = (row - M_CTX) & (LAT_N - 1), pos = (wc & 1) ? (t & 63) : (t >> 6);
                    f32x4 cs[4];
#pragma unroll
                    for (int q = 0; q < 4; ++q) cs[q] = rope[pos * 8 + 4 * (fq & 1) + q];
                    f32x4 w0, w1;
#pragma unroll
                    for (int j = 0; j < 4; ++j) {
                        const float o0 = __shfl_xor(v0[j], 32), o1 = __shfl_xor(v1[j], 32);
                        const float c0_ = cs[j >> 1][2 * (j & 1)], s0_ = cs[j >> 1][2 * (j & 1) + 1];
                        const float c1_ = cs[2 + (j >> 1)][2 * (j & 1)], s1_ = cs[2 + (j >> 1)][2 * (j & 1) + 1];
                        w0[j] = v0[j] * c0_ + sgn * o0 * s0_; w1[j] = v1[j] * c1_ + sgn * o1 * s1_; }
                    v0 = w0; v1 = w1;
                }
                if (MODE == 2) {
#pragma unroll
                    for (int j = 0; j < 4; ++j) { v0[j] = sigmoid_fast(v0[j]); v1[j] = sigmoid_fast(v1[j]); }
                }
                *(u32x4*)(dst + eoff) = pack8(v0 * qs, v1 * qs);
            }
        }
    }
    __device__ __forceinline__ void operator()(const f32x4 (&acc)[2][2][4][2], const Unit& u, int wr, int wc, int fr, int fq) const {
        const int pn = u.pn, pm = u.pm;
        bf16_t* QAB = (bf16_t*)(wsb + WS_QAB); bf16_t* KA = (bf16_t*)(wsb + WS_KA); bf16_t* VA = (bf16_t*)(wsb + WS_VA); bf16_t* KB = (bf16_t*)(wsb + WS_KB); bf16_t* VB = (bf16_t*)(wsb + WS_VB);
        bf16_t* SGNA = (bf16_t*)(wsb + WS_SGNA); bf16_t* SGSWA = (bf16_t*)(wsb + WS_SGSWA); const float* SS = (const float*)(wsb + WS_SS);
        float* o_nak = outp + OUT_NAK; float* o_nav = outp + OUT_NAV; float* o_swk = outp + OUT_SWK; float* o_swv = outp + OUT_SWV;
        float rs[2][4];
#pragma unroll
        for (int ai = 0; ai < 2; ++ai)
#pragma unroll
            for (int m = 0; m < 4; ++m) rs[ai][m] = row_rstd(SS, pm * 256 + wr * 64 + fr + ai * 128 + m * 16);
#define HALF_(MODE, bj, dst, ld, dcol, fdst, qs) half<MODE>(acc, rs, pn, bj, pm, wr, wc, fr, fq, dst, ld, dcol, fdst, qs)
        if (pn < 2)       { HALF_(0, 0, QAB, 1024, 256 * pn, nullptr, QSCALE);             asm volatile("" ::: "memory"); HALF_(0, 1, QAB, 1024, 256 * pn + 128, nullptr, QSCALE); }
        else if (pn < 4)  { HALF_(0, 0, KA, 512, 256 * (pn - 2), o_nak, 1.0f);             asm volatile("" ::: "memory"); HALF_(0, 1, KA, 512, 256 * (pn - 2) + 128, o_nak, 1.0f); }
        else if (pn < 6)  { HALF_(0, 0, VA, 512, 256 * (pn - 4), o_nav, 1.0f);             asm volatile("" ::: "memory"); HALF_(0, 1, VA, 512, 256 * (pn - 4) + 128, o_nav, 1.0f); }
        else if (pn < 8)  { HALF_(1, 0, QAB, 1024, 512 + 256 * (pn - 6), nullptr, QSCALE); asm volatile("" ::: "memory"); HALF_(1, 1, QAB, 1024, 512 + 256 * (pn - 6) + 128, nullptr, QSCALE); }
        else if (pn == 8) { HALF_(1, 0, KB, 128, 0, o_swk, 1.0f);                          asm volatile("" ::: "memory"); HALF_(0, 1, VB, 128, 0, o_swv, 1.0f); }
        else if (pn < 13) { HALF_(2, 0, SGNA, 1024, 256 * (pn - 9), nullptr, 1.0f);        asm volatile("" ::: "memory"); HALF_(2, 1, SGNA, 1024, 256 * (pn - 9) + 128, nullptr, 1.0f); }
        else              { HALF_(2, 0, SGSWA, 1024, 256 * (pn - 13), nullptr, 1.0f);      asm volatile("" ::: "memory"); HALF_(2, 1, SGSWA, 1024, 256 * (pn - 13) + 128, nullptr, 1.0f); }
#undef HALF_
    }
};

struct EpiMerge {
    static constexpr bool PERM = true, AFTER_DRAIN = false; static constexpr int MID_T = 8;
    unsigned char* wsb;
    __device__ __forceinline__ void mid(f32x4 (&acc)[2][2][4][2], const Unit& u, int wr, int wc, int fr, int fq) const {
        const bf16_t* SGA = (const bf16_t*)(wsb + WS_SGNA); const bf16_t* SGB = (const bf16_t*)(wsb + WS_SGSWA);
        int row0 = u.pm * 256 + wr * 64 + fr, col0 = u.pn * 256 + wc * 32 + 8 * fq;
        asm volatile("" : "+v"(row0), "+v"(col0));
#pragma unroll
        for (int ai = 0; ai < 2; ++ai)
#pragma unroll
            for (int mh = 0; mh < 2; ++mh) {
                u32x4 a[2][2], b[2][2];
#pragma unroll
                for (int mm = 0; mm < 2; ++mm)
#pragma unroll
                    for (int bj = 0; bj < 2; ++bj) { const unsigned off = (unsigned)(row0 + ai * 128 + (2 * mh + mm) * 16) * (unsigned)D + (unsigned)(col0 + bj * 128);
                        a[mm][bj] = *(const u32x4*)(SGA + off); b[mm][bj] = *(const u32x4*)(SGB + off); }
#pragma unroll
                for (int mm = 0; mm < 2; ++mm)
#pragma unroll
                    for (int bj = 0; bj < 2; ++bj)
#pragma unroll
                        for (int n = 0; n < 2; ++n)
#pragma unroll
                            for (int j = 0; j < 4; ++j) { const int e = 4 * n + j; const unsigned aw = a[mm][bj][e >> 1], bw = b[mm][bj][e >> 1];
                                const float sa = (e & 1) ? __uint_as_float(aw & 0xffff0000u) : __uint_as_float(aw << 16);
                                const float sb = (e & 1) ? __uint_as_float(bw & 0xffff0000u) : __uint_as_float(bw << 16);
                                acc[ai][bj][2 * mh + mm][n][j] *= sa * __builtin_amdgcn_rcpf(fmaxf(sb, 1e-30f)); }
                asm volatile("" ::: "memory");
            }
    }
    __device__ __forceinline__ void operator()(const f32x4 (&acc)[2][2][4][2], const Unit& u, int wr, int wc, int fr, int fq) const {
        const bf16_t* SGB = (const bf16_t*)(wsb + WS_SGSWA); bf16_t* O = (bf16_t*)(wsb + WS_H);
        const int row0 = u.pm * 256 + wr * 64 + fr, col0 = u.pn * 256 + wc * 32 + 8 * fq;
#pragma unroll
        for (int ai = 0; ai < 2; ++ai) {
            u32x4 sg[4][2];
#pragma unroll
            for (int m = 0; m < 4; ++m)
#pragma unroll
                for (int bj = 0; bj < 2; ++bj) sg[m][bj] = *(const u32x4*)(SGB + ((unsigned)(row0 + ai * 128 + m * 16) * (unsigned)D + (unsigned)(col0 + bj * 128)));
#pragma unroll
            for (int m = 0; m < 4; ++m)
#pragma unroll
                for (int bj = 0; bj < 2; ++bj) {
                    f32x4 o[2];
#pragma unroll
                    for (int n = 0; n < 2; ++n)
#pragma unroll
                        for (int j = 0; j < 4; ++j) { const int e = 4 * n + j; const unsigned sw = sg[m][bj][e >> 1];
                            const float s = (e & 1) ? __uint_as_float(sw & 0xffff0000u) : __uint_as_float(sw << 16);
                            o[n][j] = fmaxf(s, 1e-30f) * acc[ai][bj][m][n][j]; }
                    *(u32x4*)(O + ((unsigned)(row0 + ai * 128 + m * 16) * (unsigned)D + (unsigned)(col0 + bj * 128))) = pack8(o[0], o[1]);
                }
        }
    }
};

struct Ctx {
    LAS unsigned char* lds; int tid, lane, wave, vcu, G;
};

constexpr int TR_ROWB = 144;
__device__ __forceinline__ void transpose_item(const float* W, int N, bf16_t* WT, int ldt, int koff, int drow0, LAS unsigned char* scr, int kb, int nb, int lane) {
    const int k0 = 64 * kb, n0 = 64 * nb, kr = lane >> 4, nq = lane & 15;
    const float* src = W + (size_t)(k0 + 16 * kr) * N + n0 + 4 * nq;
    f32x4 v[16];
#pragma unroll
    for (int i = 0; i < 16; ++i) v[i] = *(const f32x4*)(src + (size_t)i * N);
#pragma unroll
    for (int e = 0; e < 4; ++e) {
        u32x4 lo, hi;
        lo.x = cvt_pk_bf16(v[0][e], v[1][e]); lo.y = cvt_pk_bf16(v[2][e], v[3][e]); lo.z = cvt_pk_bf16(v[4][e], v[5][e]); lo.w = cvt_pk_bf16(v[6][e], v[7][e]);
        hi.x = cvt_pk_bf16(v[8][e], v[9][e]); hi.y = cvt_pk_bf16(v[10][e], v[11][e]); hi.z = cvt_pk_bf16(v[12][e], v[13][e]); hi.w = cvt_pk_bf16(v[14][e], v[15][e]);
        LAS unsigned char* p = scr + (4 * nq + e) * TR_ROWB + 32 * kr;
        *(LAS u32x4*)p = lo; *(LAS u32x4*)(p + 16) = hi;
    }
    asm volatile("s_waitcnt lgkmcnt(0)" ::: "memory");
#pragma unroll
    for (int j = 0; j < 8; ++j) { const int row = 8 * j + (lane >> 3), ch = lane & 7;
        const u32x4 o = *(const LAS u32x4*)(scr + row * TR_ROWB + 16 * ch);
        *(u32x4*)(WT + (size_t)(drow0 + row) * ldt + koff + k0 + 8 * ch) = o; }
    asm volatile("s_waitcnt lgkmcnt(0)" ::: "memory");
}
__device__ __forceinline__ void tr_plain(const float* W, int K, int N, bf16_t* WT, int ldt, int koff, LAS unsigned char* scr, int item, int lane) {
    const int nblk = N / 64, kb = item / nblk, nb = item % nblk; (void)K;
    transpose_item(W, N, WT, ldt, koff, 64 * nb, scr, kb, nb, lane);
}
__device__ __forceinline__ void tr_gu(const float* W, bf16_t* WT, int up, LAS unsigned char* scr, int item, int lane) {
    const int nblk = FF / 64, kb = item / nblk, nb = item % nblk, n0 = 64 * nb;
    transpose_item(W, FF, WT, D, 0, (n0 >> 7) * 256 + (n0 & 127) + up * 128, scr, kb, nb, lane);
}
constexpr int I_GU = (D / 64) * (FF / 64), I_DN = (FF / 64) * (D / 64), I_IN = (D / 64) * (NIN / 64), I_BR = (512 / 64) * (D / 64), I_OUT = (D / 64) * (D / 64);
constexpr int I_ALL = 2 * (2 * I_GU + I_DN) + I_IN + 2 * I_BR + I_OUT;

template <bool FINAL> __device__ __forceinline__ void norm_rows(const float* xp, const float* xs, void* outp, const float* g, const float* mod, int sc_idx, int sh_idx, int row0, int stride, int lane) {
    f32x4 v[4], nv[4];
    if (row0 < M) { const f32x4* xr = (const f32x4*)(row0 < M_CTX ? xp + (size_t)row0 * D : xs + (size_t)(row0 - M_CTX) * D) + lane;
#pragma unroll
        for (int j = 0; j < 4; ++j) v[j] = xr[64 * j]; }
    for (int row = row0; row < M; row += stride) {
        const int nrow = row + stride;
        if (nrow < M) { const f32x4* xr = (const f32x4*)(nrow < M_CTX ? xp + (size_t)nrow * D : xs + (size_t)(nrow - M_CTX) * D) + lane;
#pragma unroll
            for (int j = 0; j < 4; ++j) nv[j] = xr[64 * j]; }
        float s2 = 0.f;
#pragma unroll
        for (int j = 0; j < 4; ++j) s2 += (v[j].x * v[j].x + v[j].y * v[j].y) + (v[j].z * v[j].z + v[j].w * v[j].w);
        const float rstd = 1.0f / sqrtf(wave_sum(s2) * (1.0f / D) + EPS);
        const float* md = mod + (size_t)cond_of_row(row) * MODW;
#pragma unroll
        for (int j = 0; j < 4; ++j) {
            const f32x4 gv = ((const f32x4*)g)[64 * j + lane];
            f32x4 o = v[j] * rstd * gv;
            if (FINAL) { ((f32x4*)outp)[(size_t)row * (D / 4) + 64 * j + lane] = o; }
            else {
                const f32x4 scv = ((const f32x4*)(md + sc_idx * D))[64 * j + lane], shv = ((const f32x4*)(md + sh_idx * D))[64 * j + lane];
                o = o * (scv + 1.0f) + shv;
                u32x2 w; w.x = cvt_pk_bf16(o.x, o.y); w.y = cvt_pk_bf16(o.z, o.w);
                ((u32x2*)outp)[(size_t)row * (D / 4) + 64 * j + lane] = w;
            }
        }
#pragma unroll
        for (int j = 0; j < 4; ++j) v[j] = nv[j];
    }
}

struct AttnBufs { bf16_t *OB; bf16_t *QAB; const bf16_t *KA, *VA, *KB, *VB, *CKNA, *CVNA, *CKSWA, *CVSWA; const float* relb; const float* sink; };

#define ATT_STEP(KP, VP, BIAS2, VALID) do { if (VALID) { \
        const u32x4* kp_ = (const u32x4*)(KP); float s_ = (BIAS2); \
        _Pragma("unroll") for (int c_ = 0; c_ < 8; ++c_) { const u32x4 kk_ = kp_[c_]; \
            _Pragma("unroll") for (int e_ = 0; e_ < 4; ++e_) { s_ += q[8 * c_ + 2 * e_] * __uint_as_float(kk_[e_] << 16) + q[8 * c_ + 2 * e_ + 1] * __uint_as_float(kk_[e_] & 0xffff0000u); } } \
        if (s_ > mx) { const float al_ = exp2f(mx - s_); l *= al_; _Pragma("unroll") for (int d_ = 0; d_ < 64; ++d_) o[d_] *= al_; mx = s_; } \
        const float p_ = exp2f(s_ - mx); l += p_; \
        const u32x4* vp_ = (const u32x4*)(VP); \
        _Pragma("unroll") for (int c_ = 0; c_ < 8; ++c_) { const u32x4 vv_ = vp_[c_]; \
            _Pragma("unroll") for (int e_ = 0; e_ < 4; ++e_) { o[8 * c_ + 2 * e_] += p_ * __uint_as_float(vv_[e_] << 16); o[8 * c_ + 2 * e_ + 1] += p_ * __uint_as_float(vv_[e_] & 0xffff0000u); } } \
    } } while (0)

__device__ __forceinline__ void attn_naive_item(const AttnBufs& A, int kind, int b, int head, int chunk, int lane) {
    const bool lat = kind >= 2, swa = kind & 1;
    const int t = chunk * 64 + lane;
    const int row = lat ? M_CTX + b * LAT_N + t : b * CTX_L + t;
    const int qcol = swa ? 512 + head * 64 : head * 64;
    bf16_t* qp = A.QAB + (size_t)row * 1024 + qcol;
    float q[64], o[64];
#pragma unroll
    for (int c = 0; c < 8; ++c) { const u32x4 w = ((const u32x4*)qp)[c];
#pragma unroll
        for (int e = 0; e < 4; ++e) { q[8 * c + 2 * e] = __uint_as_float(w[e] << 16); q[8 * c + 2 * e + 1] = __uint_as_float(w[e] & 0xffff0000u); } }
#pragma unroll
    for (int d = 0; d < 64; ++d) o[d] = 0.f;
    float mx = -1e30f, l = 0.f;
    if (swa) { mx = A.sink[head] * LOG2E; l = 1.f; }
    const int kvh = head >> 2;
    if (!lat) {
        const bf16_t* kb_ = swa ? A.KB + (size_t)(b * CTX_L) * 128 + kvh * 64 : A.KA + (size_t)(b * CTX_L) * 512 + head * 64;
        const bf16_t* vb_ = swa ? A.VB + (size_t)(b * CTX_L) * 128 + kvh * 64 : A.VA + (size_t)(b * CTX_L) * 512 + head * 64;
        const int ld = swa ? 128 : 512;
        for (int j = 0; j < CTX_L; ++j) ATT_STEP(kb_ + (size_t)j * ld, vb_ + (size_t)j * ld, 0.f, true);
    } else if (!swa) {
        const int r = t >> 6, c = t & 63;
        const int rs = min(max(r - 4, 0), 24), cs = min(max(c - 8, 0), 48);
        const bf16_t* kb_ = A.KA + (size_t)(M_CTX + b * LAT_N) * 512 + head * 64;
        const bf16_t* vb_ = A.VA + (size_t)(M_CTX + b * LAT_N) * 512 + head * 64;
        const float* rb = A.relb + head * (15 * 31);
        for (int i = 0; i < 8; ++i)
            for (int j = 0; j < 16; ++j) {
                const int kt = (rs + i) * 64 + cs + j;
                const float bias = rb[(rs + i - r + 7) * 31 + (cs + j - c + 15)] * LOG2E;
                ATT_STEP(kb_ + (size_t)kt * 512, vb_ + (size_t)kt * 512, bias, true);
            }
        const bf16_t* ck = A.CKNA + (size_t)(b * PAST) * 512 + head * 64; const bf16_t* cv = A.CVNA + (size_t)(b * PAST) * 512 + head * 64;
        for (int j = 0; j < PAST; ++j) ATT_STEP(ck + (size_t)j * 512, cv + (size_t)j * 512, 0.f, true);
    } else {
        const bf16_t* kb_ = A.KB + (size_t)(M_CTX + b * LAT_N) * 128 + kvh * 64;
        const bf16_t* vb_ = A.VB + (size_t)(M_CTX + b * LAT_N) * 128 + kvh * 64;
        const int t0 = chunk * 64, jlo = max(0, t0 - 128), jhi = min(LAT_N - 1, t0 + 63 + 128);
        for (int j = jlo; j <= jhi; ++j) { const int dj = j - t; ATT_STEP(kb_ + (size_t)j * 128, vb_ + (size_t)j * 128, 0.f, (dj <= 128 && dj >= -128)); }
        const bf16_t* ck = A.CKSWA + (size_t)(b * PAST) * 128 + kvh * 64; const bf16_t* cv = A.CVSWA + (size_t)(b * PAST) * 128 + kvh * 64;
        for (int j = 0; j < PAST; ++j) ATT_STEP(ck + (size_t)j * 128, cv + (size_t)j * 128, 0.f, true);
    }
    const float rl = 1.0f / l;
#pragma unroll
    for (int c = 0; c < 8; ++c) { u32x4 w;
#pragma unroll
        for (int e = 0; e < 4; ++e) w[e] = pk2(o[8 * c + 2 * e] * rl, o[8 * c + 2 * e + 1] * rl);
        ((u32x4*)qp)[c] = w; }
}
__device__ __forceinline__ void attn_naive_phase(const Ctx& F, const AttnBufs& A) {
    const int gw = F.vcu * NWAVES + F.wave, NGW = F.G * NWAVES;
    for (int it = gw; it < 4096 + 1024; it += NGW) {
        if (it < 4096) { const int chunk = it & 31, hh = (it >> 5) & 15, b = it >> 9; attn_naive_item(A, 2 + (hh >> 3), b, hh & 7, chunk, F.lane); }
        else { const int r = it - 4096, chunk = r & 3, hh = (r >> 2) & 15, b = r >> 6; attn_naive_item(A, hh >> 3, b, hh & 7, chunk, F.lane); }
    }
}


namespace att {
typedef short bf16x8 __attribute__((ext_vector_type(8)));
typedef short s16x4 __attribute__((ext_vector_type(4)));
typedef float f32x16 __attribute__((ext_vector_type(16)));
typedef float f32x2_t __attribute__((ext_vector_type(2))); typedef __bf16 bf16x2_t __attribute__((ext_vector_type(2)));
constexpr int A_K = 0, A_V = 16384, A_WSF = 32768, A_OST = 34816, A_TB = 67584, TB_ROW = 132, TB_FLOATS = 4 * 15 * TB_ROW;
static_assert(A_TB + TB_FLOATS * 4 <= RING_BYTES, "attention LDS map");
__device__ __forceinline__ int crow(int r, int hi) { return (r & 3) + 8 * (r >> 2) + 4 * hi; }
__device__ __forceinline__ unsigned cvtpk_s(float lo, float hi) { f32x2_t v = {lo, hi}; bf16x2_t b = __builtin_convertvector(v, bf16x2_t); return __builtin_bit_cast(unsigned, b); }
__device__ __forceinline__ s16x4 vtr(const LAS unsigned char* p) { typedef short v4i16_t __attribute__((ext_vector_type(4))); return __builtin_bit_cast(s16x4, __builtin_amdgcn_ds_read_tr16_b64_v4i16((LAS v4i16_t*)p)); }
__device__ __forceinline__ float halves_max(float m) { auto rr = __builtin_amdgcn_permlane32_swap(__float_as_uint(m), __float_as_uint(m), false, false); return fmaxf(__uint_as_float(rr[0]), __uint_as_float(rr[1])); }
__device__ __forceinline__ float halves_sum(float m) { auto rr = __builtin_amdgcn_permlane32_swap(__float_as_uint(m), __float_as_uint(m), false, false); return __uint_as_float(rr[0]) + __uint_as_float(rr[1]); }

template <int KIND>
__device__ __forceinline__ void attn_unit(LAS unsigned char* lds, const AttnBufs& A, int ub, int uh, int ux, int lane, int wid) {
    constexpr bool LAT = KIND >= 2, SWA = (KIND & 1) != 0, NA_LAT = KIND == 2, SWA_LAT = KIND == 3;
    const int r32 = lane & 31, hi = lane >> 5;
    int qrow0, qcol, ldk, NB, NT; const bf16_t *Kb, *Vb, *Kc, *Vc;
    int wlo = 0, whi = 1 << 30, dr0 = 0, cq = 0, qpos0 = 0, kt00 = 0, head = uh;
    if (KIND == 0) { qrow0 = ub * CTX_L + 32 * wid; qcol = uh * 64; ldk = 512; NB = 4; NT = 4;
        Kb = A.KA + (size_t)(ub * CTX_L) * 512 + uh * 64; Vb = A.VA + (size_t)(ub * CTX_L) * 512 + uh * 64; Kc = Kb; Vc = Vb; }
    else if (KIND == 1) { qrow0 = ub * CTX_L + 32 * wid; qcol = 512 + uh * 64; ldk = 128; NB = 4; NT = 4;
        Kb = A.KB + (size_t)(ub * CTX_L) * 128 + (uh >> 2) * 64; Vb = A.VB + (size_t)(ub * CTX_L) * 128 + (uh >> 2) * 64; Kc = Kb; Vc = Vb; }
    else if (KIND == 2) {
        const int r0 = 4 * ux, rw = r0 + (wid >> 1), c0 = 32 * (wid & 1);
        const int kr_lo = min(max(r0 - 4, 0), 24), kr_hi = min(max(r0 + 3 - 4, 0), 24) + 7, rs_w = min(max(rw - 4, 0), 24);
        qrow0 = M_CTX + ub * LAT_N + rw * 64 + c0; qcol = uh * 64; ldk = 512; NB = kr_hi - kr_lo + 1; NT = NB + 4;
        wlo = rs_w - kr_lo; whi = wlo + 7; dr0 = kr_lo - rw + 7; cq = c0 + r32;
        Kb = A.KA + (size_t)(M_CTX + ub * LAT_N + kr_lo * 64) * 512 + uh * 64; Vb = A.VA + (size_t)(M_CTX + ub * LAT_N + kr_lo * 64) * 512 + uh * 64;
        Kc = A.CKNA + (size_t)(ub * PAST) * 512 + uh * 64; Vc = A.CVNA + (size_t)(ub * PAST) * 512 + uh * 64; }
    else {
        head = 4 * uh + (wid >> 1); const int tb0 = max(0, ux - 2), tb1 = min(31, ux + 2);
        qpos0 = 64 * ux + 32 * (wid & 1); kt00 = 64 * tb0;
        qrow0 = M_CTX + ub * LAT_N + qpos0; qcol = 512 + head * 64; ldk = 128; NB = tb1 - tb0 + 1; NT = NB + 4;
        Kb = A.KB + (size_t)(M_CTX + ub * LAT_N + kt00) * 128 + uh * 64; Vb = A.VB + (size_t)(M_CTX + ub * LAT_N + kt00) * 128 + uh * 64;
        Kc = A.CKSWA + (size_t)(ub * PAST) * 128 + uh * 64; Vc = A.CVSWA + (size_t)(ub * PAST) * 128 + uh * 64; }
    LAS float* TB = (LAS float*)(lds + A_TB);
    if (NA_LAT) {
        const float* rb = A.relb + uh * (15 * 31);
        for (int idx = threadIdx.x; idx < TB_FLOATS; idx += NWAVES * 64) { const int s = idx / (15 * TB_ROW), rem = idx - s * (15 * TB_ROW), dr = rem / TB_ROW, i = rem - dr * TB_ROW, dc = i - 48 - s;
            TB[idx] = (dc >= 0 && dc <= 30) ? rb[dr * 31 + dc] * LOG2E : 0.f; }
    }
    bf16_t* Qw = A.QAB + (size_t)qrow0 * 1024 + qcol;
    bf16x8 qr[4];
#pragma unroll
    for (int d0 = 0; d0 < 4; ++d0) qr[d0] = *(const bf16x8*)(Qw + (size_t)r32 * 1024 + d0 * 16 + hi * 8);
    float mhat = 0.f, lsum = 0.f;
    if (SWA) { mhat = A.sink[head] * LOG2E; lsum = (hi == 0) ? 1.f : 0.f; }
    f32x16 o0, o1;
#pragma unroll
    for (int r = 0; r < 16; ++r) { o0[r] = 0.f; o1[r] = 0.f; }
    unsigned vmask = 0u;
    int lane_tb = 0;
    if (NA_LAT) {
        const int cs = min(max(cq - 8, 0), 48), s = (cq + 1) & 3;
#pragma unroll
        for (int r = 0; r < 16; ++r) { const int kc = crow(r, hi); vmask |= (kc >= cs && kc < cs + 16) ? (1u << r) : 0u; vmask |= (kc + 32 >= cs && kc + 32 < cs + 16) ? (1u << (16 + r)) : 0u; }
        lane_tb = s * 15 * TB_ROW + (63 - cq + s) + 4 * hi;
    }
    LAS float* wsf = (LAS float*)(lds + A_WSF) + wid * 64;
    const size_t koff = (size_t)lane * ldk + wid * 8, voff = (size_t)(16 * (wid & 3) + (lane >> 2)) * ldk + (wid >> 2) * 32 + (lane & 3) * 8;
    const int st_off = wid * 1024 + lane * 16;
    { const u32x4 kreg = *(const u32x4*)(Kb + koff), vreg = *(const u32x4*)(Vb + voff);
      *(LAS u32x4*)(lds + A_K + st_off) = kreg; *(LAS u32x4*)(lds + A_V + st_off) = vreg; }
    __syncthreads();
    for (int t = 0; t < NT; ++t) {
        const int buf = t & 1;
        u32x4 kreg = (u32x4){0u, 0u, 0u, 0u}, vreg = (u32x4){0u, 0u, 0u, 0u};
        if (t + 1 < NT) { const bf16_t* kt = (t + 1 < NB) ? Kb + (size_t)(t + 1) * 64 * ldk : Kc + (size_t)(t + 1 - NB) * 64 * ldk;
                          const bf16_t* vt = (t + 1 < NB) ? Vb + (size_t)(t + 1) * 64 * ldk : Vc + (size_t)(t + 1 - NB) * 64 * ldk;
                          kreg = *(const u32x4*)(kt + koff); vreg = *(const u32x4*)(vt + voff); }
        const bool band = LAT && t < NB;
        if (!(NA_LAT && band && (t < wlo || t > whi))) {
            const LAS unsigned char* kp = lds + A_K + buf * 8192 + hi * 1024 + r32 * 16;
            bf16x8 kf[8];
#pragma unroll
            for (int d0 = 0; d0 < 4; ++d0) { kf[2 * d0] = *(const LAS bf16x8*)(kp + d0 * 2048); kf[2 * d0 + 1] = *(const LAS bf16x8*)(kp + d0 * 2048 + 512); }
            f32x16 p0, p1;
            if (NA_LAT && band) {
                const LAS float* tb = TB + (dr0 + t) * TB_ROW + lane_tb;
#pragma unroll
                for (int g = 0; g < 4; ++g) { const f32x4 b0 = *(const LAS f32x4*)(tb + 8 * g), b1 = *(const LAS f32x4*)(tb + 8 * g + 32);
#pragma unroll
                    for (int e = 0; e < 4; ++e) { p0[4 * g + e] = ((vmask >> (4 * g + e)) & 1u) ? b0[e] - mhat : -1e30f; p1[4 * g + e] = ((vmask >> (16 + 4 * g + e)) & 1u) ? b1[e] - mhat : -1e30f; } }
            } else {
#pragma unroll
                for (int r = 0; r < 16; ++r) { p0[r] = -mhat; p1[r] = -mhat; }
            }
#pragma unroll
            for (int d0 = 0; d0 < 4; ++d0) { p0 = __builtin_amdgcn_mfma_f32_32x32x16_bf16(kf[2 * d0], qr[d0], p0, 0, 0, 0); p1 = __builtin_amdgcn_mfma_f32_32x32x16_bf16(kf[2 * d0 + 1], qr[d0], p1, 0, 0, 0); }
            if (SWA_LAT && band) {
                const int dl0 = kt00 + 64 * t - qpos0;
                if (dl0 - 31 < -128 || dl0 + 63 > 128) {
                    const int dlt = dl0 - r32 + 4 * hi;
#pragma unroll
                    for (int r = 0; r < 16; ++r) { const int d_ = dlt + crow(r, 0); if (d_ < -128 || d_ > 128) p0[r] = -1e30f; if (d_ + 32 < -128 || d_ + 32 > 128) p1[r] = -1e30f; }
                }
            }
            float rm = fmaxf(p0[0], p1[0]);
#pragma unroll
            for (int r = 1; r < 16; ++r) rm = fmaxf(rm, fmaxf(p0[r], p1[r]));
            rm = halves_max(rm);
            if (__any(rm > 0.f)) {
                const float dl = fmaxf(rm, 0.f); mhat += dl;
                const float f = __builtin_amdgcn_exp2f(-dl); lsum *= f;
#pragma unroll
                for (int r = 0; r < 16; ++r) { p0[r] -= dl; p1[r] -= dl; }
                if (hi == 0) wsf[r32] = f;
#pragma unroll
                for (int g = 0; g < 4; ++g) { const f32x4 fv = *(const LAS f32x4*)(wsf + 8 * g + 4 * hi);
#pragma unroll
                    for (int e = 0; e < 4; ++e) { o0[4 * g + e] *= fv[e]; o1[4 * g + e] *= fv[e]; } }
            }
            float sacc = 0.f;
#pragma unroll
            for (int r = 0; r < 16; ++r) { p0[r] = __builtin_amdgcn_exp2f(p0[r]); p1[r] = __builtin_amdgcn_exp2f(p1[r]); sacc += p0[r] + p1[r]; }
            lsum += sacc;
            u32x4 pw[4];
#pragma unroll
            for (int i = 0; i < 4; ++i) { pw[0][i] = cvtpk_s(p0[2 * i], p0[2 * i + 1]); pw[1][i] = cvtpk_s(p0[8 + 2 * i], p0[8 + 2 * i + 1]); pw[2][i] = cvtpk_s(p1[2 * i], p1[2 * i + 1]); pw[3][i] = cvtpk_s(p1[8 + 2 * i], p1[8 + 2 * i + 1]); }
            const LAS unsigned char* vp = lds + A_V + buf * 8192 + ((lane >> 4) & 1) * 32 + (lane & 3) * 8 + (4 * hi + ((lane & 15) >> 2)) * 64;
#pragma unroll
            for (int ks = 0; ks < 4; ++ks) {
                const s16x4 a0 = vtr(vp + ks * 1024), a1 = vtr(vp + ks * 1024 + 512), b0 = vtr(vp + 4096 + ks * 1024), b1 = vtr(vp + 4096 + ks * 1024 + 512);
                const bf16x8 v0 = (bf16x8){a0[0], a0[1], a0[2], a0[3], a1[0], a1[1], a1[2], a1[3]}, v1 = (bf16x8){b0[0], b0[1], b0[2], b0[3], b1[0], b1[1], b1[2], b1[3]};
                const bf16x8 pa = __builtin_bit_cast(bf16x8, pw[ks]);
                o0 = __builtin_amdgcn_mfma_f32_32x32x16_bf16(pa, v0, o0, 0, 0, 0);
                o1 = __builtin_amdgcn_mfma_f32_32x32x16_bf16(pa, v1, o1, 0, 0, 0);
            }
        }
        if (t + 1 < NT) { *(LAS u32x4*)(lds + A_K + (buf ^ 1) * 8192 + st_off) = kreg; *(LAS u32x4*)(lds + A_V + (buf ^ 1) * 8192 + st_off) = vreg; }
        __syncthreads();
    }
    const float ltot = halves_sum(lsum);
    if (hi == 0) wsf[32 + r32] = 1.0f / ltot;
    bf16_t* stg = (bf16_t*)nullptr; LAS bf16_t* sg = (LAS bf16_t*)(lds + A_OST + wid * 4096); (void)stg;
#pragma unroll
    for (int g = 0; g < 4; ++g) { const f32x4 rl = *(const LAS f32x4*)(wsf + 32 + 8 * g + 4 * hi);
#pragma unroll
        for (int e = 0; e < 4; ++e) { const int orow = 8 * g + 4 * hi + e;
            sg[orow * 64 + r32] = (bf16_t)f2bf(o0[4 * g + e] * rl[e]); sg[orow * 64 + 32 + r32] = (bf16_t)f2bf(o1[4 * g + e] * rl[e]); } }
#pragma unroll
    for (int i = 0; i < 4; ++i) { const int row = i * 8 + (lane >> 3), ch = lane & 7; const u32x4 v = *(const LAS u32x4*)(sg + row * 64 + ch * 8); *(u32x4*)(A.OB + (size_t)(qrow0 + row) * 1024 + qcol + ch * 8) = v; }
}

__device__ __forceinline__ void attn_phase(const Ctx& F, const AttnBufs& A) {
    for (int u = F.vcu; u < 1280; u += F.G) {
        if (u < 512) attn_unit<2>(F.lds, A, u >> 6, (u >> 3) & 7, u & 7, F.lane, F.wave);
        else if (u < 1024) { const int v = u - 512; attn_unit<3>(F.lds, A, v >> 6, (v >> 5) & 1, v & 31, F.lane, F.wave); }
        else if (u < 1152) { const int v = u - 1024; attn_unit<0>(F.lds, A, v >> 3, v & 7, 0, F.lane, F.wave); }
        else { const int v = u - 1152; attn_unit<1>(F.lds, A, v >> 3, v & 7, 0, F.lane, F.wave); }
    }
}
}

#define XB_TMO      128
#define XB_XCNT(j)  (256  + 64 * (j))
#define XB_XSUB(j)  (1280 + 64 * (j))
#define XB_XGEN(j)  (2304 + 64 * (j))
#define XB_TOP      3328
#define XB_TOPGEN   3392
#define XCD_BAR_WORDS 3456
#define XB_SPIN_CAP (1u << 18)

__device__ __forceinline__ unsigned xb_ld(unsigned* p)              { return __hip_atomic_load(p, __ATOMIC_RELAXED, __HIP_MEMORY_SCOPE_AGENT); }
__device__ __forceinline__ unsigned xb_add(unsigned* p, unsigned v) { return __hip_atomic_fetch_add(p, v, __ATOMIC_RELAXED, __HIP_MEMORY_SCOPE_AGENT); }
__device__ __forceinline__ unsigned xb_xcc_id() { return (unsigned)__builtin_amdgcn_s_getreg((3 << 11) | 20) & 0xFu; }
#define XB_SPIN(cond, bar) do { unsigned _sp = 0; while (cond) { __builtin_amdgcn_s_sleep(1); \
    if ((++_sp & 255u) == 0u) { if (xb_ld(&(bar)[XB_TMO])) break; if (_sp > XB_SPIN_CAP) { atomicAdd(&(bar)[XB_TMO], 1u); break; } } } } while (0)

struct XcdBarrier {
    unsigned* bar; unsigned x;
    volatile LAS unsigned* st;
};

__device__ __forceinline__ XcdBarrier xcd_barrier_post(unsigned* bar, volatile LAS unsigned* st) {
    XcdBarrier b; b.bar = bar; b.x = xb_xcc_id(); b.st = st;
    if (threadIdx.x == 0) (void)xb_add(&bar[XB_XCNT(b.x)], 1u);
    return b;
}
__device__ __forceinline__ void xcd_barrier_complete(unsigned* bar, unsigned x, unsigned& nloc, unsigned& nx) {
    const unsigned G = gridDim.x * gridDim.y * gridDim.z;
    unsigned sum, cnt, mine, sp = 0u;
    for (;;) {
        sum = 0u; cnt = 0u; mine = 0u;
#pragma unroll
        for (unsigned j = 0; j < 16; ++j) { const unsigned c = xb_ld(&bar[XB_XCNT(j)]); sum += c; cnt += (c > 0u) ? 1u : 0u; mine = (j == x) ? c : mine; }
        if (sum == G) break;
        __builtin_amdgcn_s_sleep(1);
        if ((++sp & 255u) == 0u) { if (xb_ld(&bar[XB_TMO])) break; if (sp > XB_SPIN_CAP) { atomicAdd(&bar[XB_TMO], 1u); break; } }
    }
    nloc = mine > 0u ? mine : 1u; nx = cnt > 0u ? cnt : 1u;
}

__device__ __forceinline__ void xcd_barrier(const XcdBarrier& b) {
    asm volatile("s_waitcnt vmcnt(0)" ::: "memory");
    __syncthreads();
    if (threadIdx.x == 0) {
        unsigned* bar = b.bar;
        __builtin_amdgcn_s_waitcnt(0);
        unsigned nloc = b.st[0], nx = b.st[1];
        if (nloc == 0u) { xcd_barrier_complete(bar, b.x, nloc, nx); b.st[0] = nloc; b.st[1] = nx; }
        const unsigned old = xb_add(&bar[XB_XSUB(b.x)], 1u);
        const unsigned gen = old / nloc;
        if (old + 1u == (gen + 1u) * nloc) {
            __builtin_amdgcn_fence(__ATOMIC_RELEASE, "agent");
            asm volatile("s_waitcnt vmcnt(0)" ::: "memory");
            const unsigned og = xb_add(&bar[XB_TOP], 1u);
            const unsigned tg = og / nx;
            if (og + 1u == (tg + 1u) * nx) xb_add(&bar[XB_TOPGEN], 1u);
            else XB_SPIN(xb_ld(&bar[XB_TOPGEN]) == tg, bar);
            __builtin_amdgcn_fence(__ATOMIC_ACQUIRE, "agent");
            xb_add(&bar[XB_XGEN(b.x)], 1u);
            asm volatile("s_waitcnt vmcnt(0)" ::: "memory");
        } else {
            XB_SPIN(xb_ld(&bar[XB_XGEN(b.x)]) == gen, bar);
            __builtin_amdgcn_fence(__ATOMIC_ACQUIRE, "agent");
            asm volatile("s_waitcnt vmcnt(0)" ::: "memory");
        }
    }
    __syncthreads();
}

struct Args { const float* in[26]; float* out; unsigned char* ws; int ph_lo, ph_hi; };
constexpr int N_PHASES = 12;

__global__ void __launch_bounds__(NWAVES * 64, 2) fwd_kernel(Args args) {
    extern __shared__ __attribute__((aligned(16))) unsigned char lds_raw[];
    Ctx F;
    F.lds = (LAS unsigned char*)lds_raw;
    F.tid = threadIdx.x; F.lane = F.tid & 63; F.wave = __builtin_amdgcn_readfirstlane(F.tid >> 6);
    F.G = gridDim.x; { const int bx = blockIdx.x; F.vcu = (F.G % 8 == 0) ? (bx % 8) * (F.G / 8) + bx / 8 : bx; }
#define ws (args.ws)
#define x_prompt (args.in[0])
#define x_sample (args.in[1])
#define Y (args.out + OUT_Y)
#define MOD ((float*)(ws + WS_MOD))
#define ROPE ((float2*)(ws + WS_ROPE))
#define GS ((float*)(ws + WS_GS))
#define B2IN ((float*)(ws + WS_B2IN))
#define B2GU ((float*)(ws + WS_B2GU))
#define SS ((float*)(ws + WS_SS))
#define WGU1 ((bf16_t*)(ws + WS_WGU1))
#define WD1 ((bf16_t*)(ws + WS_WD1))
#define WIN ((bf16_t*)(ws + WS_WIN))
#define WB ((bf16_t*)(ws + WS_WB))
#define WOUT ((bf16_t*)(ws + WS_WOUT))
#define WGU2 ((bf16_t*)(ws + WS_WGU2))
#define WD2 ((bf16_t*)(ws + WS_WD2))
#define H ((bf16_t*)(ws + WS_H))
#define H2 ((bf16_t*)(ws + WS_H2))
#define ACT ((bf16_t*)(ws + WS_ACT))
#define QAB ((bf16_t*)(ws + WS_QAB))
#define KA ((bf16_t*)(ws + WS_KA))
#define VA ((bf16_t*)(ws + WS_VA))
#define KB ((bf16_t*)(ws + WS_KB))
#define VB ((bf16_t*)(ws + WS_VB))
#define SGNA ((bf16_t*)(ws + WS_SGNA))
#define SGSWA ((bf16_t*)(ws + WS_SGSWA))
#define TMP ((bf16_t*)(ws + WS_TMP))
#define CKNA ((bf16_t*)(ws + WS_CKNA))
#define CVNA ((bf16_t*)(ws + WS_CVNA))
#define CKSWA ((bf16_t*)(ws + WS_CKSWA))
#define CVSWA ((bf16_t*)(ws + WS_CVSWA))
    const int gw = F.vcu * NWAVES + F.wave, NGW = F.G * NWAVES;
    const int lo = args.ph_lo, hi = args.ph_hi;
#define TS(i) do { if (TIMING_PHASE >= 0 && blockIdx.x == 0 && F.tid == 0) { if ((i) == TIMING_PHASE) *(volatile LAS unsigned long long*)(F.lds + MISC_OFF + 64) = __builtin_amdgcn_s_memrealtime(); \
        if ((i) == TIMING_PHASE + 1) *(volatile LAS unsigned long long*)(F.lds + MISC_OFF + 72) = __builtin_amdgcn_s_memrealtime(); } } while (0)
#define IN(k) (lo <= (k) && (k) < hi)
#define REPS(k) for (int rep_ = 0; rep_ < ((PROBE_REP == (k)) ? 2 : 1); ++rep_, (PROBE_REP == (k) && rep_ == 1) ? xcd_barrier(bar) : (void)0)
#if MK_N_LAUNCHES == 1
    for (int u = F.tid; u < (LDS_BYTES - LDSCTL_OFF) / 4; u += NWAVES * 64) ((LAS unsigned*)(F.lds + LDSCTL_OFF))[u] = 0u;
    __syncthreads();
    XcdBarrier bar = xcd_barrier_post((unsigned*)(ws + WS_CTL) + CW_BAR, (volatile LAS unsigned*)(F.lds + MISC_OFF) + 8);
#define SEAM(k) do { if (IN(k) && IN((k) + 1)) { if ((k) == 0) cg::this_grid().sync(); else xcd_barrier(bar); } } while (0)
#else
    XcdBarrier bar; bar.bar = nullptr; bar.x = 0; bar.st = nullptr;
#define SEAM(k) do { } while (0)
#endif

    TS(0);
    if (IN(0)) REPS(0) {
        if (blockIdx.x < 72) {
            LAS float* S = (LAS float*)F.lds; LAS float* RED = (LAS float*)(F.lds + 49152);
            const float* c_lat = args.in[6]; const float* c_ctx = args.in[7]; const float* w_ada = args.in[8]; const float* b_ada = args.in[9];
            for (int idx = F.tid; idx < NCOND * D; idx += NWAVES * 64) { const int i = idx >> 10, k = idx & 1023; const float c = (i == 0) ? c_ctx[k] : c_lat[(i - 1) * D + k]; S[k * 12 + i] = c / (1.0f + __expf(-c)); }
            __syncthreads();
            for (int it = blockIdx.x; it < 72; it += F.G) {
                const int n0 = it * 128, k0 = F.wave * 128;
                float a[NCOND][2];
#pragma unroll
                for (int i = 0; i < NCOND; ++i) { a[i][0] = 0.f; a[i][1] = 0.f; }
#pragma unroll 8
                for (int kk = 0; kk < 128; ++kk) { const int k = k0 + kk; const float2 w = *(const float2*)(w_ada + (size_t)k * MODW + n0 + 2 * F.lane);
#pragma unroll
                    for (int i = 0; i < NCOND; ++i) { const float s = S[k * 12 + i]; a[i][0] += s * w.x; a[i][1] += s * w.y; } }
#pragma unroll
                for (int i = 0; i < NCOND; ++i) { RED[(F.wave * NCOND + i) * 128 + 2 * F.lane] = a[i][0]; RED[(F.wave * NCOND + i) * 128 + 2 * F.lane + 1] = a[i][1]; }
                __syncthreads();
                for (int idx = F.tid; idx < NCOND * 128; idx += NWAVES * 64) { const int i = idx >> 7, c = idx & 127; float s = b_ada[n0 + c];
#pragma unroll
                    for (int w = 0; w < NWAVES; ++w) s += RED[(w * NCOND + i) * 128 + c];
                    MOD[(size_t)i * MODW + n0 + c] = s; }
                __syncthreads();
            }
        }
        if (blockIdx.x == F.G - 1) {
            for (int idx = F.tid; idx < 64 * 16; idx += NWAVES * 64) { const int pos = idx >> 4, i = idx & 15; const float fr_ = powf(10000.0f, -(float)i / 16.0f); const float ang = (float)pos * fr_; ROPE[idx] = make_float2(cosf(ang), sinf(ang)); }
        }
        {
            LAS unsigned char* scr = F.lds + F.wave * 16384;
            const int gwr = ((int)blockIdx.x >= 72 ? (int)blockIdx.x - 72 : (int)blockIdx.x + (F.G - 72)) * NWAVES + F.wave;
            for (int it = gwr; it < I_ALL; it += NGW) {
                int r = it;
                if (r < I_GU) { tr_gu(args.in[11], WGU1, 0, scr, r, F.lane); continue; } r -= I_GU;
                if (r < I_GU) { tr_gu(args.in[12], WGU1, 1, scr, r, F.lane); continue; } r -= I_GU;
                if (r < I_DN) { tr_plain(args.in[13], FF, D, WD1, FF, 0, scr, r, F.lane); continue; } r -= I_DN;
                if (r < I_IN) { tr_plain(args.in[15], D, NIN, WIN, D, 0, scr, r, F.lane); continue; } r -= I_IN;
                if (r < I_BR) { tr_plain(args.in[18], 512, D, WB, D, 0, scr, r, F.lane); continue; } r -= I_BR;
                if (r < I_BR) { tr_plain(args.in[19], 512, D, WB, D, 512, scr, r, F.lane); continue; } r -= I_BR;
                if (r < I_OUT) { tr_plain(args.in[20], D, D, WOUT, D, 0, scr, r, F.lane); continue; } r -= I_OUT;
                if (r < I_GU) { tr_gu(args.in[22], WGU2, 0, scr, r, F.lane); continue; } r -= I_GU;
                if (r < I_GU) { tr_gu(args.in[23], WGU2, 1, scr, r, F.lane); continue; } r -= I_GU;
                tr_plain(args.in[24], FF, D, WD2, FF, 0, scr, r, F.lane);
            }
        }
        {
            const int gt = (F.vcu * NWAVES * 64) + F.tid, NT = F.G * NWAVES * 64;
            constexpr int N4A = 8 * 256 * 512 / 4, N4B = 8 * 256 * 128 / 4;
            for (int i = gt; i < 2 * N4A + 2 * N4B; i += NT) {
                int r = i; const float* src; bf16_t* dst;
                if (r < N4A) { src = args.in[2]; dst = CKNA; } else if ((r -= N4A) < N4A) { src = args.in[3]; dst = CVNA; } else if ((r -= N4A) < N4B) { src = args.in[4]; dst = CKSWA; } else { r -= N4B; src = args.in[5]; dst = CVSWA; }
                const f32x4 v = ((const f32x4*)src)[r]; u32x2 w; w.x = pk2(v.x, v.y); w.y = pk2(v.z, v.w); ((u32x2*)dst)[r] = w;
            }
        }
    }
    SEAM(0); TS(1);
    if (IN(1)) REPS(1) {
        norm_rows<false>(x_prompt, x_sample, H, args.in[10], MOD, 1, 0, gw, NGW, F.lane);
        { const int gt = (F.vcu * NWAVES * 64) + F.tid, NT = F.G * NWAVES * 64;
          for (int i = gt; i < 2 * NCOND * D; i += NT) { const int st = i / (NCOND * D), r = i - st * NCOND * D, c = r >> 10, k = r & 1023;
              GS[i] = (st == 0 ? args.in[14][k] : args.in[21][k]) * (1.0f + MOD[(size_t)c * MODW + (st == 0 ? 4 : 7) * D + k]); } }
        for (int it = gw; it < (NIN + 2 * FF) / 16; it += NGW) {
            const bool in_ = it < NIN / 16; const int n0 = 16 * (in_ ? it : it - NIN / 16), nl = F.lane & 15, kq = F.lane >> 4;
            const bf16_t* wp = (in_ ? WIN : WGU2) + (size_t)(n0 + nl) * D + 8 * kq;
            const float* shp = MOD + (size_t)min(nl, NCOND - 1) * MODW + (in_ ? 3 : 6) * D + 8 * kq;
            f32x4 acc4 = (f32x4){0.f, 0.f, 0.f, 0.f};
#pragma unroll 8
            for (int s = 0; s < 32; ++s) {
                const pg8::bf16x8 bfr = *(const pg8::bf16x8*)(wp + 32 * s);
                f32x4 a0 = *(const f32x4*)(shp + 32 * s), a1 = *(const f32x4*)(shp + 32 * s + 4);
                if (nl >= NCOND) { a0 = (f32x4){0.f, 0.f, 0.f, 0.f}; a1 = a0; }
                u32x4 aw; aw.x = cvt_pk_bf16(a0.x, a0.y); aw.y = cvt_pk_bf16(a0.z, a0.w); aw.z = cvt_pk_bf16(a1.x, a1.y); aw.w = cvt_pk_bf16(a1.z, a1.w);
                acc4 = __builtin_amdgcn_mfma_f32_16x16x32_bf16(__builtin_bit_cast(pg8::bf16x8, aw), bfr, acc4, 0, 0, 0);
            }
            float* dst = in_ ? B2IN : B2GU; const int ldn = in_ ? NIN : 2 * FF;
#pragma unroll
            for (int r = 0; r < 4; ++r) { const int c = 4 * kq + r; if (c < NCOND) dst[(size_t)c * ldn + n0 + nl] = acc4[r]; }
        }
    }
    SEAM(1); TS(2);
    if (IN(2)) REPS(2) {
        pg8::Gemm g{H, WGU1, D, D, M, 2 * FF, D}; pg8::StaticOrder S; S.init(M, 2 * FF, F.G, (int)blockIdx.x);
        EpiSwiGLU<false> E{ws};
        pg8::gemm_phase<EpiSwiGLU<false>, pg8::StaticOrder, true, true>(F.lds, g, S, E);
    }
    SEAM(2); TS(3);
    if (IN(3)) REPS(3) {
        pg8::Gemm g{ACT, WD1, FF, FF, M, D, FF}; pg8::StaticOrder S; S.init(M, D, F.G, (int)blockIdx.x);
        EpiResid<0> E{x_prompt, x_sample, Y, ws};
        pg8::gemm_phase<EpiResid<0>, pg8::StaticOrder, true, true>(F.lds, g, S, E);
    }
    SEAM(3); TS(4);
    if (IN(4)) {
        pg8::Gemm g{H2, WIN, D, D, M, NIN, D}; pg8::StaticOrder S; S.init(M, NIN, F.G, (int)blockIdx.x);
        LAS unsigned char* ropel = F.lds + LDSCTL_OFF + 1024;
        for (int i = F.tid; i < 64 * 16 / 2; i += NWAVES * 64) ((LAS f32x4*)ropel)[i] = ((const f32x4*)ROPE)[i];
        __syncthreads();
        EpiIn E{ws, args.out, ropel};
        pg8::gemm_phase<EpiIn, pg8::StaticOrder, true, true>(F.lds, g, S, E);
    }
    SEAM(4); TS(5);
    if (IN(5)) {
        AttnBufs A{QAB, QAB, KA, VA, KB, VB, CKNA, CVNA, CKSWA, CVSWA, args.in[16], args.in[17]};
#if ATTN_DEBUG
        { const int gt = (F.vcu * NWAVES * 64) + F.tid, NT_ = F.G * NWAVES * 64;
          for (size_t i = gt; i < (size_t)M * 1024 / 8; i += NT_) ((u32x4*)H)[i] = ((const u32x4*)QAB)[i]; }
        cg::this_grid().sync();
        att::attn_phase(F, A);
        { AttnBufs A2{H, H, KA, VA, KB, VB, CKNA, CVNA, CKSWA, CVSWA, args.in[16], args.in[17]}; attn_naive_phase(F, A2); }
        cg::this_grid().sync();
        { float sd[4] = {0.f, 0.f, 0.f, 0.f}, sr[4] = {0.f, 0.f, 0.f, 0.f};
          const int gt = (F.vcu * NWAVES * 64) + F.tid, NT_ = F.G * NWAVES * 64;
          for (size_t i = gt; i < (size_t)M * 1024 / 8; i += NT_) {
              const int row = (int)(i >> 7), col = (int)(i & 127) * 8; const int ty = (row >= M_CTX ? 2 : 0) + (col >= 512 ? 1 : 0);
              const u32x4 a = ((const u32x4*)QAB)[i], b = ((const u32x4*)H)[i]; float d2 = 0.f, r2 = 0.f;
#pragma unroll
              for (int e = 0; e < 4; ++e) { const float a0 = __uint_as_float(a[e] << 16), a1 = __uint_as_float(a[e] & 0xffff0000u), b0 = __uint_as_float(b[e] << 16), b1 = __uint_as_float(b[e] & 0xffff0000u);
                  d2 += (a0 - b0) * (a0 - b0) + (a1 - b1) * (a1 - b1); r2 += b0 * b0 + b1 * b1; }
#pragma unroll
              for (int k = 0; k < 4; ++k) { sd[k] += (ty == k) ? d2 : 0.f; sr[k] += (ty == k) ? r2 : 0.f; } }
#pragma unroll
          for (int k = 0; k < 4; ++k) { const float d = wave_sum(sd[k]), r = wave_sum(sr[k]); if (F.lane == 0) { atomicAdd((float*)(ws + WS_CTL) + 64 * (2 * k), d); atomicAdd((float*)(ws + WS_CTL) + 64 * (2 * k + 1), r); } } }
#else
        if (PROBE_REP == 5) { AttnBufs A2{H2, QAB, KA, VA, KB, VB, CKNA, CVNA, CKSWA, CVSWA, args.in[16], args.in[17]}; att::attn_phase(F, A2); xcd_barrier(bar); }
        att::attn_phase(F, A);
#endif
    }
    SEAM(5); TS(6);
    if (IN(6)) {
        pg8::Gemm g{QAB, WB, D, D, M, D, D}; pg8::StaticOrder S; S.init(M, D, F.G, (int)blockIdx.x);
        EpiMerge E{ws};
        pg8::gemm_phase<EpiMerge, pg8::StaticOrder, true, true>(F.lds, g, S, E);
    }
    SEAM(6); TS(7); TS(8);
    if (IN(8)) {
        pg8::Gemm g{H, WOUT, D, D, M, D, D}; pg8::StaticOrder S; S.init(M, D, F.G, (int)blockIdx.x);
        EpiResid<1> E{nullptr, nullptr, Y, ws};
        pg8::gemm_phase<EpiResid<1>, pg8::StaticOrder, true, true>(F.lds, g, S, E);
    }
    SEAM(8); TS(9);
    if (IN(9)) REPS(9) {
        pg8::Gemm g{H2, WGU2, D, D, M, 2 * FF, D}; pg8::StaticOrder S; S.init(M, 2 * FF, F.G, (int)blockIdx.x);
        EpiSwiGLU<true> E{ws};
        pg8::gemm_phase<EpiSwiGLU<true>, pg8::StaticOrder, true, true>(F.lds, g, S, E);
    }
    SEAM(9); TS(10);
    if (IN(10)) {
        pg8::Gemm g{ACT, WD2, FF, FF, M, D, FF}; pg8::StaticOrder S; S.init(M, D, F.G, (int)blockIdx.x);
        EpiResid<2> E{nullptr, nullptr, Y, ws};
        pg8::gemm_phase<EpiResid<2>, pg8::StaticOrder, true, true>(F.lds, g, S, E);
    }
    SEAM(10); TS(11);
    if (IN(11)) {
        norm_rows<true>(Y, Y + (size_t)M_CTX * D, Y, args.in[25], nullptr, 0, 0, gw, NGW, F.lane);
#if ATTN_DEBUG
        { const float* cw = (const float*)(ws + WS_CTL); bool bad[4];
#pragma unroll
          for (int k = 0; k < 4; ++k) bad[k] = !(cw[64 * (2 * k)] <= ATTN_DEBUG_TOL * cw[64 * (2 * k + 1)]);
          asm volatile("s_waitcnt vmcnt(0)" ::: "memory"); __syncthreads();
          if (blockIdx.x == 0 && F.tid == 0) { const float qn = __builtin_nanf("");
              if (bad[0]) args.out[OUT_NAK] = qn;
              if (bad[1]) args.out[OUT_NAV] = qn;
              if (bad[2]) args.out[OUT_SWK] = qn;
              if (bad[3]) args.out[OUT_SWV] = qn; } }
#endif
    }
    if (TIMING_PHASE >= 0) { xcd_barrier(bar); TS(12);
        if (blockIdx.x == 0 && F.tid == 0) { const unsigned long long ts_a = *(volatile LAS unsigned long long*)(F.lds + MISC_OFF + 64), ts_b = *(volatile LAS unsigned long long*)(F.lds + MISC_OFF + 72); const unsigned long long t_end = __builtin_amdgcn_s_memrealtime() + (unsigned long long)TIMING_ALPHA * (ts_b - ts_a);
            while (__builtin_amdgcn_s_memrealtime() < t_end) __builtin_amdgcn_s_sleep(16); } }
#undef TS
#undef IN
#undef SEAM
#undef REPS
#undef ws
#undef x_prompt
#undef x_sample
#undef Y
#undef MOD
#undef ROPE
#undef GS
#undef B2IN
#undef B2GU
#undef SS
#undef WGU1
#undef WD1
#undef WIN
#undef WB
#undef WOUT
#undef WGU2
#undef WD2
#undef H
#undef H2
#undef ACT
#undef QAB
#undef KA
#undef VA
#undef KB
#undef VB
#undef SGNA
#undef SGSWA
#undef TMP
#undef CKNA
#undef CVNA
#undef CKSWA
#undef CVSWA
}

extern "C" void kernel_launch(void* const* d_in, const int* in_sizes, int n_in, void* d_out, int out_size, void* d_ws, size_t ws_size, hipStream_t stream) {
    static int grid = 0;
    if (grid == 0) {
        if (n_in != 26 || out_size != (int)OUT_END || ws_size < WS_END) { fprintf(stderr, "kernel_launch: unexpected shapes (n_in %d out %d ws %zu); nothing launched\n", n_in, out_size, ws_size); grid = -1; return; }
        int dev = 0, cus = 0, per_cu = 0;
        if (hipGetDevice(&dev) != hipSuccess || hipDeviceGetAttribute(&cus, hipDeviceAttributeMultiprocessorCount, dev) != hipSuccess) { grid = -1; return; }
        if (hipFuncSetAttribute((const void*)fwd_kernel, hipFuncAttributeMaxDynamicSharedMemorySize, LDS_BYTES) != hipSuccess) { fprintf(stderr, "kernel_launch: hipFuncSetAttribute failed\n"); grid = -1; return; }
        if (hipOccupancyMaxActiveBlocksPerMultiprocessor(&per_cu, (const void*)fwd_kernel, NWAVES * 64, LDS_BYTES) != hipSuccess || per_cu < 1) { fprintf(stderr, "kernel_launch: occupancy query says %d\n", per_cu); per_cu = 1; }
        (void)hipGetLastError();
        grid = cus;
    }
    if (grid < 0) return;
    if (hipMemsetAsync((char*)d_ws + WS_CTL, 0, CTL_ZERO_BYTES, stream) != hipSuccess) { fprintf(stderr, "kernel_launch: memset failed\n"); return; }
    Args a{};
    for (int i = 0; i < 26; ++i) a.in[i] = (const float*)d_in[i];
    a.out = (float*)d_out; a.ws = (unsigned char*)d_ws;
#if MK_N_LAUNCHES == 1
    a.ph_lo = 0; a.ph_hi = N_PHASES;
    void* kargs[] = {&a};
    hipError_t e = hipLaunchCooperativeKernel((const void*)fwd_kernel, dim3(grid), dim3(NWAVES * 64), kargs, LDS_BYTES, stream);
    if (e != hipSuccess) fprintf(stderr, "cooperative launch failed: %s (grid %d)\n", hipGetErrorString(e), grid);
#else
    for (int p = 0; p < N_PHASES; ++p) { a.ph_lo = p; a.ph_hi = p + 1; hipLaunchKernelGGL(fwd_kernel, dim3(grid), dim3(NWAVES * 64), LDS_BYTES, stream, a); }
#endif
}
```
